# Optimizing an MI355X kernel written in HIP

```python
import math
import jax
import jax.numpy as jnp
from jax import lax
import numpy as np

D_MODEL = 2048
BATCH = 4
SEQ = 4096
DEPTH = 1

N_META = 16
MIX_WIDTH = D_MODEL
RW_WIDTH = MIX_WIDTH // 2
RW_HEAD = 64
RW_HEADS = RW_WIDTH // RW_HEAD
RW_LORA_W = 64
RW_LORA_A = 64
RW_GN_EPS = 64e-5
RW_SHIFT_COLS = 3 * RW_WIDTH + RW_LORA_W + RW_LORA_A
DN_WIDTH = MIX_WIDTH - RW_WIDTH
DN_HEAD = 128
DN_HEADS = DN_WIDTH // DN_HEAD
CONV_W = 4
CHUNK = 64
NORM_EPS = 1e-6
IN_COLS = RW_SHIFT_COLS + RW_WIDTH + 3 * DN_WIDTH + 2 * DN_HEADS + DN_WIDTH

kernel_name = "hymba_rwkv7_gated_deltanet_layer"


def rms_norm(x, w, eps=NORM_EPS):
    xf = x.astype(jnp.float32)
    y = xf * lax.rsqrt(jnp.mean(xf * xf, axis=-1, keepdims=True) + eps)
    return (y * w.astype(jnp.float32)).astype(x.dtype)


def l2_normalize(x, eps=1e-6):
    return x * lax.rsqrt(jnp.sum(x * x, axis=-1, keepdims=True) + eps)


def token_shift(p, mu):
    prev = jnp.pad(p, ((0, 0), (1, 0), (0, 0)))[:, :-1]
    return p + (prev - p) * mu


def rwkv7_mix(p_shift, gate, w0, w2, a0, a2, k_k, k_a, r_k, gn_w, gn_b):
    B, L, _ = p_shift.shape
    p_shift = p_shift.astype(jnp.float32)
    r, k, v, lw, la = jnp.split(
        p_shift, [RW_WIDTH, 2 * RW_WIDTH, 3 * RW_WIDTH, 3 * RW_WIDTH + RW_LORA_W], axis=-1)
    w_log = -jax.nn.softplus(-(w0 + jnp.tanh(lw) @ w2)) - 0.5
    decay = jnp.exp(-jnp.exp(w_log))
    a = jax.nn.sigmoid(a0 + la @ a2)
    hd = lambda t: t.reshape(B, L, RW_HEADS, RW_HEAD)
    kk = l2_normalize(hd(k * k_k))
    k = k * (1.0 + (a - 1.0) * k_a)
    rh, kh, vh, dh, ah = hd(r), hd(k), hd(v), hd(decay), hd(a)
    tm = lambda t: jnp.moveaxis(t, 1, 0)
    xs = (tm(rh), tm(dh), tm(kh), tm(vh), tm(kk), tm(kk * ah))

    def step(S, inp):
        r_t, w_t, k_t, v_t, kk_t, b_t = inp
        sa = jnp.einsum('bhvk,bhk->bhv', S, kk_t)
        S = (S * w_t[:, :, None, :] - sa[..., None] * b_t[:, :, None, :]
             + v_t[..., None] * k_t[:, :, None, :])
        y = jnp.einsum('bhvk,bhk->bhv', S, r_t)
        return S, y

    S0 = jnp.zeros((B, RW_HEADS, RW_HEAD, RW_HEAD), jnp.float32)
    _, y = lax.scan(step, S0, xs)
    y = jnp.moveaxis(y, 0, 1)
    mean = jnp.mean(y, axis=-1, keepdims=True)
    var = jnp.mean(jnp.square(y - mean), axis=-1, keepdims=True)
    y = ((y - mean) * lax.rsqrt(var + RW_GN_EPS)).reshape(B, L, RW_WIDTH) * gn_w + gn_b
    bonus = jnp.sum(rh * kh * hd(jnp.broadcast_to(r_k, r.shape)), axis=-1, keepdims=True) * vh
    y = y + bonus.reshape(B, L, RW_WIDTH)
    return y * jax.nn.silu(gate.astype(jnp.float32))


def causal_dwconv(u, w):
    C = u.shape[-1]
    return lax.conv_general_dilated(
        u, w[:, None, :], window_strides=(1,), padding=[(CONV_W - 1, 0)],
        dimension_numbers=('NWC', 'WIO', 'NWC'), feature_group_count=C)


def gated_delta_mix(qkv, b, alpha, z, conv_w, A_log, dt_bias, norm_w):
    B, L, _ = qkv.shape
    f32 = jnp.float32
    qkv = jax.nn.silu(causal_dwconv(qkv.astype(f32), conv_w.astype(f32)))
    q, k, v = jnp.split(qkv, [DN_WIDTH, 2 * DN_WIDTH], axis=-1)
    hd = lambda t: t.reshape(B, L, DN_HEADS, DN_HEAD)
    q = l2_normalize(hd(q)) * (DN_HEAD ** -0.5)
    k = l2_normalize(hd(k))
    v = hd(v)
    beta = jax.nn.sigmoid(b.astype(f32))
    g = -jnp.exp(A_log) * jax.nn.softplus(alpha.astype(f32) + dt_bias)

    pad_f = (-N_META) % CHUNK
    pad_b = (-(L + pad_f)) % CHUNK
    Lp = L + pad_f + pad_b
    Nc = Lp // CHUNK
    pad4 = ((0, 0), (pad_f, pad_b), (0, 0), (0, 0))
    pad3 = ((0, 0), (pad_f, pad_b), (0, 0))
    ch4 = lambda t: jnp.transpose(jnp.pad(t, pad4), (0, 2, 1, 3)).reshape(B, DN_HEADS, Nc, CHUNK, DN_HEAD)
    ch3 = lambda t: jnp.transpose(jnp.pad(t, pad3), (0, 2, 1)).reshape(B, DN_HEADS, Nc, CHUNK)
    q, k, v = ch4(q), ch4(k), ch4(v)
    beta, g = ch3(beta), ch3(g)

    g = jnp.cumsum(g, axis=-1)
    k_beta = k * beta[..., None]
    v_beta = v * beta[..., None]
    tri_incl = jnp.tril(jnp.ones((CHUNK, CHUNK), bool))
    tri_strict = jnp.tril(jnp.ones((CHUNK, CHUNK), bool), -1)
    decay_mask = jnp.exp(jnp.where(tri_incl, g[..., :, None] - g[..., None, :], -jnp.inf))
    M = jnp.where(tri_strict, jnp.einsum('bhncd,bhnsd->bhncs', k_beta, k) * decay_mask, 0.0)
    eye = jnp.eye(CHUNK, dtype=f32)
    T = lax.linalg.triangular_solve(M + eye, jnp.broadcast_to(eye, M.shape),
                                    left_side=True, lower=True, unit_diagonal=True)
    u = jnp.einsum('bhncs,bhnsd->bhncd', T, v_beta)
    w = jnp.einsum('bhncs,bhnsd->bhncd', T, k_beta * jnp.exp(g)[..., None])
    attn = jnp.where(tri_incl, jnp.einsum('bhncd,bhnsd->bhncs', q, k) * decay_mask, 0.0)

    def chunk_step(S, inp):
        q_c, k_c, u_c, w_c, g_c, a_c = inp
        v_new = u_c - jnp.einsum('bhck,bhkv->bhcv', w_c, S)
        o = (jnp.einsum('bhck,bhkv->bhcv', q_c * jnp.exp(g_c)[..., None], S)
             + jnp.einsum('bhcs,bhsv->bhcv', a_c, v_new))
        g_last = g_c[..., -1]
        S = (S * jnp.exp(g_last)[..., None, None]
             + jnp.einsum('bhck,bhcv->bhkv', k_c * jnp.exp(g_last[..., None] - g_c)[..., None], v_new))
        return S, o

    cm = lambda t: jnp.moveaxis(t, 2, 0)
    S0 = jnp.zeros((B, DN_HEADS, DN_HEAD, DN_HEAD), f32)
    _, o = lax.scan(chunk_step, S0, (cm(q), cm(k), cm(u), cm(w), cm(g), cm(attn)))
    o = jnp.moveaxis(o, 0, 2).reshape(B, DN_HEADS, Lp, DN_HEAD)
    o = jnp.transpose(o, (0, 2, 1, 3))[:, pad_f:pad_f + L]
    o = o * lax.rsqrt(jnp.mean(o * o, axis=-1, keepdims=True) + NORM_EPS) * norm_w
    o = o * jax.nn.silu(hd(z.astype(f32)))
    return o.reshape(B, L, DN_WIDTH)


def hybrid_layer(h, norm_w, w_in, shift_mu, rw_w0, rw_w2, rw_a0, rw_a2, rw_k_k, rw_k_a,
                 rw_r_k, rw_gn_w, rw_gn_b, dn_conv_w, dn_A_log, dn_dt_bias, dn_norm_w, w_out):
    u = rms_norm(h, norm_w)
    p = u @ w_in
    s1 = RW_SHIFT_COLS
    s2 = s1 + RW_WIDTH
    s3 = s2 + 3 * DN_WIDTH
    s4 = s3 + DN_HEADS
    s5 = s4 + DN_HEADS
    rw_p, rw_gate, dn_qkv, dn_b, dn_a, dn_z = jnp.split(p, [s1, s2, s3, s4, s5], axis=-1)
    y_a = rwkv7_mix(token_shift(rw_p.astype(jnp.float32), shift_mu), rw_gate, rw_w0, rw_w2,
                    rw_a0, rw_a2, rw_k_k, rw_k_a, rw_r_k, rw_gn_w, rw_gn_b)
    y_b = gated_delta_mix(dn_qkv, dn_b, dn_a, dn_z, dn_conv_w, dn_A_log, dn_dt_bias, dn_norm_w)
    y = jnp.concatenate([y_a, y_b], axis=-1).astype(h.dtype)
    return h + y @ w_out


def setup_inputs(seed: int = 0) -> dict:
    key = jax.random.key(seed)
    ks = jax.random.split(key, 20)
    f32 = jnp.float32
    nrm = lambda k, shape, s: s * jax.random.normal(k, shape, f32)
    x = nrm(ks[0], (BATCH, SEQ, D_MODEL), 1.0)
    meta_tokens = nrm(ks[1], (N_META, D_MODEL), 1.0)
    norm_w = 1.0 + nrm(ks[2], (DEPTH, D_MODEL), 0.02)
    w_in = nrm(ks[3], (DEPTH, D_MODEL, IN_COLS), D_MODEL ** -0.5)
    rw_shift_mu = jax.random.uniform(ks[4], (DEPTH, RW_SHIFT_COLS), f32)
    rw_w0 = jax.random.uniform(ks[5], (DEPTH, RW_WIDTH), f32, -6.0, 1.0)
    rw_w2 = nrm(ks[6], (DEPTH, RW_LORA_W, RW_WIDTH), 0.3 * RW_LORA_W ** -0.5)
    rw_a0 = nrm(ks[7], (DEPTH, RW_WIDTH), 0.1)
    rw_a2 = nrm(ks[8], (DEPTH, RW_LORA_A, RW_WIDTH), 0.3 * RW_LORA_A ** -0.5)
    rw_k_k = 0.85 + nrm(ks[9], (DEPTH, RW_WIDTH), 0.05)
    rw_k_a = 1.0 + nrm(ks[10], (DEPTH, RW_WIDTH), 0.05)
    rw_r_k = nrm(ks[11], (DEPTH, RW_WIDTH), 0.1)
    rw_gn_w = 1.0 + nrm(ks[12], (DEPTH, RW_WIDTH), 0.02)
    rw_gn_b = nrm(ks[13], (DEPTH, RW_WIDTH), 0.02)
    dn_conv_w = nrm(ks[14], (DEPTH, CONV_W, 3 * DN_WIDTH), CONV_W ** -0.5)
    dn_A_log = jnp.log(jax.random.uniform(ks[15], (DEPTH, DN_HEADS), f32, 1.0, 16.0))
    dt = jnp.exp(jax.random.uniform(ks[16], (DEPTH, DN_HEADS), f32, math.log(1e-3), math.log(1e-1)))
    dn_dt_bias = dt + jnp.log(-jnp.expm1(-dt))
    dn_norm_w = 1.0 + nrm(ks[17], (DEPTH, DN_HEAD), 0.02)
    w_out = nrm(ks[18], (DEPTH, MIX_WIDTH, D_MODEL), MIX_WIDTH ** -0.5)
    final_norm_w = 1.0 + nrm(ks[19], (D_MODEL,), 0.02)
    return {"x": x, "meta_tokens": meta_tokens, "norm_w": norm_w, "w_in": w_in,
            "rw_shift_mu": rw_shift_mu, "rw_w0": rw_w0, "rw_w2": rw_w2, "rw_a0": rw_a0,
            "rw_a2": rw_a2, "rw_k_k": rw_k_k, "rw_k_a": rw_k_a, "rw_r_k": rw_r_k,
            "rw_gn_w": rw_gn_w, "rw_gn_b": rw_gn_b, "dn_conv_w": dn_conv_w,
            "dn_A_log": dn_A_log, "dn_dt_bias": dn_dt_bias, "dn_norm_w": dn_norm_w,
            "w_out": w_out, "final_norm_w": final_norm_w}


def reference(x, meta_tokens, norm_w, w_in, rw_shift_mu, rw_w0, rw_w2, rw_a0, rw_a2,
              rw_k_k, rw_k_a, rw_r_k, rw_gn_w, rw_gn_b, dn_conv_w, dn_A_log, dn_dt_bias,
              dn_norm_w, w_out, final_norm_w):
    B = x.shape[0]
    meta = jnp.broadcast_to(meta_tokens.astype(x.dtype)[None], (B, N_META, x.shape[-1]))
    h = jnp.concatenate([meta, x], axis=1)
    for l in range(DEPTH):
        h = hybrid_layer(h, norm_w[l], w_in[l], rw_shift_mu[l], rw_w0[l], rw_w2[l], rw_a0[l],
                         rw_a2[l], rw_k_k[l], rw_k_a[l], rw_r_k[l], rw_gn_w[l], rw_gn_b[l],
                         dn_conv_w[l], dn_A_log[l], dn_dt_bias[l], dn_norm_w[l], w_out[l])
    h = rms_norm(h, final_norm_w)
    return h[:, N_META:]
```

```cpp
#include <hip/hip_runtime.h>
#include <hip/hip_cooperative_groups.h>
#include <cstdio>
#include <cstdint>
namespace cg = cooperative_groups;
#ifndef TESTMODE
#define TESTMODE 0
#endif

#define LAS __attribute__((address_space(3)))
typedef unsigned short bf16_t;
typedef short bf16x8 __attribute__((ext_vector_type(8)));
typedef float f32x4 __attribute__((ext_vector_type(4)));
typedef unsigned u32x2 __attribute__((ext_vector_type(2)));
typedef unsigned u32x4 __attribute__((ext_vector_type(4)));

constexpr int NB = 4, SEQ = 4096, NMETA = 16, LT = SEQ + NMETA, DM = 2048;
constexpr int NREAL = NB * SEQ;
constexpr int TOK = NB * LT;
constexpr int MP = 16640;
constexpr int NP = 8448;
constexpr int C_R = 0, C_K = 1024, C_V = 2048, C_G = 3072, C_Z = 4096, C_DQ = 5120, C_DK = 6144, C_DV = 7168;
constexpr int C_LW = 8192, C_LA = 8256, C_DB = 8320, C_DA = 8328;
constexpr int NCH = 65;
constexpr int LDS_BYTES = 147456;

constexpr size_t MiB = 1u << 20;
constexpr size_t WS_ROWSS = 500 * MiB;
constexpr size_t WS_BAR = 512 * 1024;
constexpr size_t WS_CNT = 512 * 1024 + 16384;
constexpr size_t WS_DNG = 256 * 1024;
constexpr size_t WS_WOUTT = 1 * MiB;
constexpr size_t WS_W2T = 9 * MiB;
constexpr size_t WS_A2T = 9 * MiB + 256 * 1024;
constexpr size_t WS_P = 10 * MiB;
constexpr size_t WS_U = 279 * MiB;
constexpr size_t WS_WINT = 344 * MiB;
constexpr size_t WS_DNP = 279 * MiB;
constexpr size_t WS_RWP = 426 * MiB;
constexpr size_t DNP_BLK = 73728;
constexpr size_t WS_END = 502 * MiB;

struct Params {
    const float* x; const float* meta; const float* norm_w; const float* w_in; const float* mu; const float* w0; const float* w2;
    const float* a0; const float* a2; const float* k_k; const float* k_a; const float* r_k; const float* gn_w; const float* gn_b;
    const float* conv_w; const float* A_log; const float* dt_bias; const float* dn_norm_w; const float* w_out; const float* fnorm_w;
    float* out; unsigned char* ws;
};

typedef float f32x2_t __attribute__((ext_vector_type(2)));
typedef __bf16 bf16x2_t __attribute__((ext_vector_type(2)));
__device__ __forceinline__ unsigned cvt_pk_bf16(float lo, float hi) { const f32x2_t v = {lo, hi}; return __builtin_bit_cast(unsigned, __builtin_convertvector(v, bf16x2_t)); }
__device__ __forceinline__ unsigned cvt_pk_bf16_asm(float lo, float hi) { unsigned r; asm volatile("v_cvt_pk_bf16_f32 %0, %1, %2" : "=v"(r) : "v"(lo), "v"(hi)); return r; }
__device__ __forceinline__ int opaque_tid() { int t = threadIdx.x; asm volatile("" : "+v"(t)); return t; }
__device__ __forceinline__ float bf_lo(unsigned w) { return __uint_as_float(w << 16); }
__device__ __forceinline__ float bf_hi(unsigned w) { return __uint_as_float(w & 0xffff0000u); }
__device__ __forceinline__ float bf2f(bf16_t b) { return __uint_as_float(((unsigned)b) << 16); }
__device__ __forceinline__ int rowof(int b, int tp) { return tp < NMETA ? NREAL + b * NMETA + tp : b * SEQ + tp - NMETA; }
__device__ __forceinline__ float sigmoidf_(float x) { return __builtin_amdgcn_rcpf(1.f + __expf(-x)); }
__device__ __forceinline__ float siluf_(float x) { return x * __builtin_amdgcn_rcpf(1.f + __expf(-x)); }
__device__ __forceinline__ float softplusf_(float x) { return fmaxf(x, 0.f) + log1pf(__expf(-fabsf(x))); }
__device__ __forceinline__ float dppf(float x, const int ctrl_sel) {
    int v = __float_as_int(x), r;
    if (ctrl_sel == 0) r = __builtin_amdgcn_update_dpp(0, v, 0xB1, 0xF, 0xF, false);
    else if (ctrl_sel == 1) r = __builtin_amdgcn_update_dpp(0, v, 0x4E, 0xF, 0xF, false);
    else if (ctrl_sel == 2) r = __builtin_amdgcn_update_dpp(0, v, 0x141, 0xF, 0xF, false);
    else r = __builtin_amdgcn_update_dpp(0, v, 0x140, 0xF, 0xF, false);
    return __int_as_float(r);
}
__device__ __forceinline__ float sum8(float x) { x += dppf(x, 0); x += dppf(x, 1); x += dppf(x, 2); return x; }
__device__ __forceinline__ float sum16(float x) { x = sum8(x); x += dppf(x, 3); return x; }
__device__ __forceinline__ bf16x8 ldfrag(const unsigned char* base, int ld_elems, int r0, int k0, int lane) {
    const int lo = ((lane & 15) * ld_elems + (lane >> 4) * 8) * 2;
    return *(const bf16x8*)(base + lo + (r0 * ld_elems + k0) * 2);
}
#define MFMA16(a, b, c) __builtin_amdgcn_mfma_f32_16x16x32_bf16((a), (b), (c), 0, 0, 0)

namespace pg8 {
#define PG8_LAS __attribute__((address_space(3)))
constexpr int BM = 256, BK = 64, HALF = 128, HTB = HALF * BK * 2, STAGE_BYTES = 8 * HTB, NXCD = 8, WGM = 8;
__host__ __device__ __forceinline__ int lds_byte(int r, int c) { const int st = (r >> 4) * 2 + (c >> 5), rr = r & 15, cc = c & 31, ob = rr * 64 + cc * 2; return st * 1024 + (ob ^ (((ob >> 9) & 1) << 5)); }
__host__ __device__ __forceinline__ void stage_rc(int b, int& R, int& C) { const int st = b / 1024, sb = b % 1024, swz = sb ^ (((sb >> 9) & 1) << 5); R = (st >> 1) * 16 + swz / 64; C = (st & 1) * 32 + (swz % 64) / 2; }
__host__ __device__ __forceinline__ int perm32(int rho) { const int n = rho >> 4, i = rho & 15; return 8 * (i >> 2) + 4 * n + (i & 3); }
struct Unit { int pm, pn; };
struct Gemm { const bf16_t* A; const bf16_t* Bt; int M, N, K, lda; };
struct StaticOrder {
    int nM, nN, nwg, G, c;
    __host__ __device__ void init(int M, int N, int G_, int c_) { nM = M / BM; nN = N / BM; nwg = nM * nN; G = G_; c = c_; }
    __host__ __device__ bool next(int i, Unit& u) const {
        const long L = (long)i * G + c; if (L >= nwg) return false;
        int wgid = (int)L; { const int q = nwg / NXCD, r = nwg % NXCD, xcd = wgid % NXCD, off = wgid / NXCD; wgid = (xcd < r ? xcd * (q + 1) : r * (q + 1) + (xcd - r) * q) + off; }
        const int nig = WGM * nN, gid = wgid / nig, fm = gid * WGM, gsz = (nM - fm) < WGM ? (nM - fm) : WGM;
        u.pm = fm + ((wgid % nig) % gsz); u.pn = (wgid % nig) / gsz; return true;
    }
    __device__ __forceinline__ void a_ready(const Unit&) const {}
    __device__ __forceinline__ void done(const Unit&) const {}
};
struct EpiBf16 {
    static constexpr bool PERM = true;
    bf16_t* O; int ldc;
    __device__ __forceinline__ void operator()(const f32x4 (&acc)[2][2][4][2], const Unit& u, int wr, int wc, int fr, int fq) const {
        const int row0 = u.pm * BM + wr * 64 + fr; const int col0 = u.pn * BM + wc * 32 + 8 * fq;
#pragma unroll
        for (int ai = 0; ai < 2; ++ai)
#pragma unroll
            for (int m = 0; m < 4; ++m) { bf16_t* rowp = O + (size_t)(row0 + ai * HALF + m * 16) * ldc + col0;
#pragma unroll
                for (int bj = 0; bj < 2; ++bj) { const f32x4 v0 = acc[ai][bj][m][0], v1 = acc[ai][bj][m][1];
                    u32x4 w; w.x = cvt_pk_bf16_asm(v0[0], v0[1]); w.y = cvt_pk_bf16_asm(v0[2], v0[3]); w.z = cvt_pk_bf16_asm(v1[0], v1[1]); w.w = cvt_pk_bf16_asm(v1[2], v1[3]);
                    *(u32x4*)(rowp + bj * HALF) = w; } }
    }
};
struct EpiResid {
    static constexpr bool PERM = false;
    const float* base; float* out; int ldc; float* rowss;
    __device__ __forceinline__ void operator()(const f32x4 (&acc)[2][2][4][2], const Unit& u, int wr, int wc, int fr, int fq) const {
        const int row0 = u.pm * BM + wr * 64 + fr, col0 = u.pn * BM + wc * 32 + 4 * fq;
#pragma unroll
        for (int ai = 0; ai < 2; ++ai)
#pragma unroll
            for (int m = 0; m < 4; ++m) { const int row = row0 + ai * HALF + m * 16; const size_t off = (size_t)row * ldc + col0; float ss = 0.f;
#pragma unroll
                for (int bj = 0; bj < 2; ++bj)
#pragma unroll
                    for (int n = 0; n < 2; ++n) { const f32x4 bs = *(const f32x4*)(base + off + bj * HALF + n * 16); const f32x4 v = bs + acc[ai][bj][m][n];
                        *(f32x4*)(out + off + bj * HALF + n * 16) = v; ss += v[0] * v[0] + v[1] * v[1] + v[2] * v[2] + v[3] * v[3]; }
                ss += __shfl_xor(ss, 16); ss += __shfl_xor(ss, 32);
                if (fq == 0) rowss[(size_t)row * 32 + u.pn * 4 + wc] = ss; }
    }
};

struct EpiResidNorm {
    static constexpr bool PERM = false;
    const float* base; float* out; int ldc; float* rowss; unsigned* cnt; const float* fw;
    __device__ __forceinline__ void operator()(f32x4 (&acc)[2][2][4][2], const Unit& u, int wr, int wc, int fr, int fq) const {
        const int row0 = u.pm * BM + wr * 64 + fr, col0 = u.pn * BM + wc * 32 + 4 * fq;
#pragma unroll
        for (int ai = 0; ai < 2; ++ai)
#pragma unroll
            for (int m = 0; m < 4; ++m) { const int row = row0 + ai * HALF + m * 16; const size_t off = (size_t)row * ldc + col0; float ss = 0.f;
#pragma unroll
                for (int bj = 0; bj < 2; ++bj)
#pragma unroll
                    for (int n = 0; n < 2; ++n) { const f32x4 bs = *(const f32x4*)(base + off + bj * HALF + n * 16); const f32x4 v = bs + acc[ai][bj][m][n];
                        acc[ai][bj][m][n] = v; ss += v[0] * v[0] + v[1] * v[1] + v[2] * v[2] + v[3] * v[3]; }
                ss += __shfl_xor(ss, 16); ss += __shfl_xor(ss, 32);
                if (fq == 0) __hip_atomic_store(rowss + (size_t)row * 32 + u.pn * 4 + wc, ss, __ATOMIC_RELAXED, __HIP_MEMORY_SCOPE_AGENT); }
        asm volatile("s_waitcnt vmcnt(0)" ::: "memory");
        unsigned* c = cnt + (u.pm * 2 + wr) * 64;
        if ((threadIdx.x & 63) == 0) (void)__hip_atomic_fetch_add(c, 1u, __ATOMIC_RELAXED, __HIP_MEMORY_SCOPE_AGENT);
        {   unsigned spins = 0;
            while ((unsigned)__builtin_amdgcn_readfirstlane((int)__hip_atomic_load(c, __ATOMIC_RELAXED, __HIP_MEMORY_SCOPE_AGENT)) < 32u) { __builtin_amdgcn_s_sleep(2); if (++spins > (1u << 22)) break; } }
        __builtin_amdgcn_fence(__ATOMIC_ACQUIRE, "agent");
        asm volatile("s_waitcnt vmcnt(0)" ::: "memory");
        f32x4 fwv[2][2];
#pragma unroll
        for (int bj = 0; bj < 2; ++bj)
#pragma unroll
            for (int n = 0; n < 2; ++n) fwv[bj][n] = *(const f32x4*)(fw + col0 + bj * HALF + n * 16);
#pragma unroll
        for (int ai = 0; ai < 2; ++ai)
#pragma unroll
            for (int m = 0; m < 4; ++m) { const int row = row0 + ai * HALF + m * 16; const size_t off = (size_t)row * ldc + col0;
                const f32x4 p0 = *(const f32x4*)(rowss + (size_t)row * 32 + fq * 8), p1 = *(const f32x4*)(rowss + (size_t)row * 32 + fq * 8 + 4);
                float t = ((p0[0] + p0[1]) + (p0[2] + p0[3])) + ((p1[0] + p1[1]) + (p1[2] + p1[3]));
                t += __shfl_xor(t, 16); t += __shfl_xor(t, 32);
                const float sc = rsqrtf(t * (1.f / 2048.f) + 1e-6f);
#pragma unroll
                for (int bj = 0; bj < 2; ++bj)
#pragma unroll
                    for (int n = 0; n < 2; ++n) { const f32x4 v = acc[ai][bj][m][n], w = fwv[bj][n];
                        *(f32x4*)(out + off + bj * HALF + n * 16) = (f32x4){v[0] * sc * w[0], v[1] * sc * w[1], v[2] * sc * w[2], v[3] * sc * w[3]}; } }
    }
};
struct PanelOrder {
    int c;
    __device__ bool next(int i, Unit& u) const { if (i >= 2) return false; const int x = c & 7, y = c >> 3; u.pm = 32 * i + 4 * x + (y >> 3); u.pn = y & 7; return true; }
    __device__ __forceinline__ void a_ready(const Unit&) const {}
    __device__ __forceinline__ void done(const Unit&) const {}
};

template <class Epi, class Sched, bool ALIGN_EPI = false, bool SP2 = false>
__device__ __forceinline__ void gemm_phase(PG8_LAS unsigned char* lds, const Gemm g, const Sched& S, const Epi& E) {
    const int tid = opaque_tid(), wid = __builtin_amdgcn_readfirstlane(tid >> 6), lane = tid & 63, wr = wid >> 2, wc = wid & 3, fr = lane & 15, fq = lane >> 4;
    const int K = g.K, nt = K / BK, lda = g.lda;
    unsigned voffA[2], voffB[2];
#pragma unroll
    for (int i = 0; i < 2; ++i) { int R, C; stage_rc(tid * 16 + i * 8192, R, C); const int Rb = Epi::PERM ? ((R & ~31) + perm32(R & 31)) : R;
        voffA[i] = (unsigned)(R * lda + C) * 2u; voffB[i] = (unsigned)(Rb * K + C) * 2u; }
    const size_t kstep = (size_t)(BK * 2);
    const size_t hstepA = (size_t)HALF * lda * 2, hstepB = (size_t)HALF * K * 2;
    const size_t tstepA = 2 * hstepA, tstepB = 2 * hstepB;
    const unsigned ldsw = (unsigned)wid * 1024u;
    const int aoff = lds_byte(wr * 64 + fr, fq * 8), boff = lds_byte(wc * 32 + fr, fq * 8);
#define PG8_SA(b, h) (((b) * 2 + (h)) * HTB)
#define PG8_SB(b, h) ((4 + (b) * 2 + (h)) * HTB)
#define PG8_STAGE(bufoff, gbase, voff) do { _Pragma("unroll") for (int _i = 0; _i < 2; ++_i) \
        __builtin_amdgcn_global_load_lds((const unsigned*)((const char*)(gbase) + (voff)[_i]), (PG8_LAS unsigned*)(lds + (bufoff) + ldsw + _i * 8192), 16, 0, 0); } while (0)
#define PG8_LDA(dst, b, h) do { _Pragma("unroll") for (int m = 0; m < 4; ++m) _Pragma("unroll") for (int k = 0; k < 2; ++k) dst[m][k] = *(const PG8_LAS bf16x8*)(lds + PG8_SA(b, h) + aoff + m * 2048 + k * 1024); } while (0)
#define PG8_LDB(dst, b, h) do { _Pragma("unroll") for (int n = 0; n < 2; ++n) _Pragma("unroll") for (int k = 0; k < 2; ++k) dst[n][k] = *(const PG8_LAS bf16x8*)(lds + PG8_SB(b, h) + boff + n * 2048 + k * 1024); } while (0)
#define PG8_MMA(ai, bj, At, Bt) do { __builtin_amdgcn_s_setprio(1); _Pragma("unroll") for (int m = 0; m < 4; ++m) _Pragma("unroll") for (int n = 0; n < 2; ++n) _Pragma("unroll") for (int k = 0; k < 2; ++k) \
        acc[ai][bj][m][n] = __builtin_amdgcn_mfma_f32_16x16x32_bf16(Bt[n][k], At[m][k], acc[ai][bj][m][n], 0, 0, 0); __builtin_amdgcn_s_setprio(0); } while (0)
#define PG8_WAIT_V(n) asm volatile("s_waitcnt vmcnt(" #n ")" ::: "memory")
#define PG8_WAIT_L(n) asm volatile("s_waitcnt lgkmcnt(" #n ")" ::: "memory")
#define PG8_BAR __builtin_amdgcn_s_barrier()
#define PG8_SCHED __builtin_amdgcn_sched_barrier(0)
    Unit cur, nxt; int ui = 0;
    if (!S.next(0, cur)) return;
    f32x4 acc[2][2][4][2];
#pragma unroll
    for (int a = 0; a < 2; ++a)
#pragma unroll
        for (int b = 0; b < 2; ++b)
#pragma unroll
            for (int m = 0; m < 4; ++m)
#pragma unroll
                for (int n = 0; n < 2; ++n) acc[a][b][m][n] = (f32x4){0.f, 0.f, 0.f, 0.f};
    bf16x8 At[4][2], B0[2][2], B1[2][2];
    const char* cA = (const char*)g.A + (size_t)cur.pm * tstepA; const char* cB = (const char*)g.Bt + (size_t)cur.pn * tstepB;
    S.a_ready(cur);
    if constexpr (SP2) {
        PG8_STAGE(PG8_SB(0, 0), cB, voffB); PG8_STAGE(PG8_SB(0, 1), cB + hstepB, voffB); PG8_STAGE(PG8_SA(0, 0), cA, voffA); PG8_STAGE(PG8_SA(0, 1), cA + hstepA, voffA);
        if (wr == 1) PG8_BAR;
        PG8_WAIT_V(2); PG8_BAR;
        PG8_STAGE(PG8_SB(1, 0), cB + kstep, voffB); PG8_STAGE(PG8_SA(1, 0), cA + kstep, voffA); PG8_STAGE(PG8_SB(1, 1), cB + hstepB + kstep, voffB);
        PG8_WAIT_V(6); PG8_BAR;
    } else {
    PG8_STAGE(PG8_SB(0, 0), cB, voffB); PG8_STAGE(PG8_SA(0, 0), cA, voffA); PG8_STAGE(PG8_SB(0, 1), cB + hstepB, voffB); PG8_STAGE(PG8_SA(0, 1), cA + hstepA, voffA);
    if (wr == 1) PG8_BAR;
    PG8_WAIT_V(4); PG8_BAR;
    PG8_STAGE(PG8_SB(1, 0), cB + kstep, voffB); PG8_STAGE(PG8_SA(1, 0), cA + kstep, voffA); PG8_STAGE(PG8_SB(1, 1), cB + hstepB + kstep, voffB);
    PG8_WAIT_V(6); PG8_BAR;
    }
    for (;;) {
        const bool has_next = S.next(ui + 1, nxt);
        const char* nA = has_next ? (const char*)g.A + (size_t)nxt.pm * tstepA : cA; const char* nB = has_next ? (const char*)g.Bt + (size_t)nxt.pn * tstepB : cB;
        for (int t = 0; t < nt; t += 2) {
            const bool last = (t == nt - 2);
            const char* a1 = cA + (size_t)(t + 1) * kstep;
            const char* a2 = last ? nA : cA + (size_t)(t + 2) * kstep; const char* b2 = last ? nB : cB + (size_t)(t + 2) * kstep;
            const char* a3 = a2 + kstep; const char* b3 = b2 + kstep;
            if (last && has_next) S.a_ready(nxt);
            if constexpr (SP2) {
            PG8_LDB(B0, 0, 0); PG8_LDB(B1, 0, 1); PG8_SCHED; PG8_LDA(At, 0, 0); PG8_STAGE(PG8_SA(1, 1), a1 + hstepA, voffA);
            PG8_WAIT_V(8); PG8_WAIT_L(0); PG8_BAR; PG8_MMA(0, 0, At, B0); PG8_MMA(0, 1, At, B1); PG8_BAR; PG8_SCHED;
            PG8_LDA(At, 0, 1); PG8_STAGE(PG8_SB(0, 0), b2, voffB); PG8_STAGE(PG8_SB(0, 1), b2 + hstepB, voffB); PG8_STAGE(PG8_SA(0, 0), a2, voffA);
            PG8_WAIT_V(8); PG8_WAIT_L(0); PG8_BAR; PG8_MMA(1, 0, At, B0); PG8_MMA(1, 1, At, B1); PG8_BAR; PG8_SCHED;
            PG8_LDB(B0, 1, 0); PG8_LDB(B1, 1, 1); PG8_SCHED; PG8_LDA(At, 1, 0); PG8_STAGE(PG8_SA(0, 1), a2 + hstepA, voffA);
            PG8_WAIT_V(8); PG8_WAIT_L(0); PG8_BAR; PG8_MMA(0, 0, At, B0); PG8_MMA(0, 1, At, B1); PG8_BAR; PG8_SCHED;
            PG8_LDA(At, 1, 1); PG8_STAGE(PG8_SB(1, 0), b3, voffB); PG8_STAGE(PG8_SB(1, 1), b3 + hstepB, voffB); PG8_STAGE(PG8_SA(1, 0), a3, voffA);
            PG8_WAIT_V(8); PG8_WAIT_L(0); PG8_BAR; PG8_MMA(1, 0, At, B0); PG8_MMA(1, 1, At, B1); PG8_BAR; PG8_SCHED;
            } else {
            PG8_LDB(B0, 0, 0); PG8_SCHED; PG8_LDA(At, 0, 0); PG8_STAGE(PG8_SA(1, 1), a1 + hstepA, voffA);
            PG8_WAIT_L(8); PG8_BAR; PG8_WAIT_L(0); PG8_MMA(0, 0, At, B0); PG8_BAR; PG8_SCHED;
            PG8_LDB(B1, 0, 1); PG8_STAGE(PG8_SB(0, 0), b2, voffB);
            PG8_BAR; PG8_WAIT_L(0); PG8_MMA(0, 1, At, B1); PG8_BAR;
            PG8_LDA(At, 0, 1); PG8_STAGE(PG8_SA(0, 0), a2, voffA);
            PG8_BAR; PG8_WAIT_L(0); PG8_MMA(1, 0, At, B0); PG8_BAR; PG8_SCHED;
            PG8_STAGE(PG8_SB(0, 1), b2 + hstepB, voffB);
            PG8_WAIT_V(6); PG8_BAR; PG8_MMA(1, 1, At, B1); PG8_BAR;
            PG8_LDB(B0, 1, 0); PG8_SCHED; PG8_LDA(At, 1, 0); PG8_STAGE(PG8_SA(0, 1), a2 + hstepA, voffA);
            PG8_WAIT_L(8); PG8_BAR; PG8_WAIT_L(0); PG8_MMA(0, 0, At, B0); PG8_BAR; PG8_SCHED;
            PG8_LDB(B1, 1, 1); PG8_STAGE(PG8_SB(1, 0), b3, voffB);
            PG8_BAR; PG8_WAIT_L(0); PG8_MMA(0, 1, At, B1); PG8_BAR;
            PG8_LDA(At, 1, 1); PG8_STAGE(PG8_SA(1, 0), a3, voffA);
            PG8_BAR; PG8_WAIT_L(0); PG8_MMA(1, 0, At, B0); PG8_BAR; PG8_SCHED;
            PG8_STAGE(PG8_SB(1, 1), b3 + hstepB, voffB);
            PG8_WAIT_V(6); PG8_BAR; PG8_MMA(1, 1, At, B1); PG8_BAR;
            }
        }
        if constexpr (ALIGN_EPI) { if (wr == 0) PG8_BAR; }
        E(acc, cur, wr, wc, fr, fq); S.done(cur);
        if (!has_next) break;
#pragma unroll
        for (int a = 0; a < 2; ++a)
#pragma unroll
            for (int b = 0; b < 2; ++b)
#pragma unroll
                for (int m = 0; m < 4; ++m)
#pragma unroll
                    for (int n = 0; n < 2; ++n) acc[a][b][m][n] = (f32x4){0.f, 0.f, 0.f, 0.f};
        cur = nxt; cA = nA; cB = nB; ++ui;
        if constexpr (ALIGN_EPI) { if (wr == 1) PG8_BAR; }
    }
    PG8_WAIT_V(0);
    if constexpr (!ALIGN_EPI) { if (wr == 0) PG8_BAR; }
    PG8_BAR;
#undef PG8_SA
#undef PG8_SB
#undef PG8_STAGE
#undef PG8_LDA
#undef PG8_LDB
#undef PG8_MMA
#undef PG8_WAIT_V
#undef PG8_WAIT_L
#undef PG8_BAR
#undef PG8_SCHED
}
}

__device__ __forceinline__ int refcol_win(int j) {
    if (j < 3072) return j;
    if (j < 4096) return 3200 + (j - 3072);
    if (j < 5120) return 7312 + (j - 4096);
    if (j < 8192) return 4224 + (j - 5120);
    if (j < 8320) return 3072 + (j - 8192);
    if (j < 8336) return 7296 + (j - 8320);
    return -1;
}
struct TJob { const float* src; bf16_t* dst; int src_ld, dst_ld, j0, k0, K; bool winmap; };
__device__ __forceinline__ TJob p0_decode(const Params& p, int job) {
    constexpr int J_WIN = (NP / 64) * 16, J_WOUT = (DM / 64) * 16, J_L = 16;
    TJob t;
    if (job < J_WIN) { t.src = p.w_in; t.src_ld = 8336; t.dst = (bf16_t*)(p.ws + WS_WINT); t.dst_ld = DM; t.j0 = (job >> 4) * 64; t.k0 = (job & 15) * 128; t.K = DM; t.winmap = true; }
    else if (job < J_WIN + J_WOUT) { const int q = job - J_WIN; t.src = p.w_out; t.src_ld = DM; t.dst = (bf16_t*)(p.ws + WS_WOUTT); t.dst_ld = DM; t.j0 = (q >> 4) * 64; t.k0 = (q & 15) * 128; t.K = DM; t.winmap = false; }
    else if (job < J_WIN + J_WOUT + J_L) { const int q = job - J_WIN - J_WOUT; t.src = p.w2; t.src_ld = 1024; t.dst = (bf16_t*)(p.ws + WS_W2T); t.dst_ld = 64; t.j0 = q * 64; t.k0 = 0; t.K = 64; t.winmap = false; }
    else { const int q = job - J_WIN - J_WOUT - J_L; t.src = p.a2; t.src_ld = 1024; t.dst = (bf16_t*)(p.ws + WS_A2T); t.dst_ld = 64; t.j0 = q * 64; t.k0 = 0; t.K = 64; t.winmap = false; }
    return t;
}
__device__ __forceinline__ void p0_load(const TJob& t, int tid, float (&v)[16]) {
    const int jj = tid & 63, j = t.j0 + jj; const int rc = t.winmap ? refcol_win(j) : j;
#pragma unroll
    for (int i = 0; i < 16; ++i) { const int k = t.k0 + i * 8 + (tid >> 6); v[i] = (rc >= 0 && k < t.K) ? t.src[(size_t)k * t.src_ld + rc] : 0.f; }
}
__device__ __forceinline__ void phase0(const Params& p, unsigned char* lds) {
    float* tile = (float*)lds;
    const int tid = opaque_tid(), G = gridDim.x, bid = blockIdx.x;
    constexpr int NJ = (NP / 64) * 16 + (DM / 64) * 16 + 32;
    {
        float v[16]; int job = bid;
        TJob t = p0_decode(p, job < NJ ? job : 0);
        if (job < NJ) p0_load(t, tid, v);
        while (job < NJ) {
            { const int jj = tid & 63;
#pragma unroll
              for (int i = 0; i < 16; ++i) tile[(i * 8 + (tid >> 6)) * 65 + jj] = v[i]; }
            __syncthreads();
            const int nxt = job + G; const TJob tn = p0_decode(p, nxt < NJ ? nxt : 0);
            if (nxt < NJ) p0_load(tn, tid, v);
            { const int jj = tid >> 3, kg = tid & 7;
#pragma unroll
              for (int half = 0; half < 2; ++half) { const int kb = half * 64 + kg * 8;
                  if (t.k0 + kb < t.K) { float x[8];
#pragma unroll
                      for (int i = 0; i < 8; ++i) x[i] = tile[(kb + i) * 65 + jj];
                      u32x4 w; w.x = cvt_pk_bf16(x[0], x[1]); w.y = cvt_pk_bf16(x[2], x[3]); w.z = cvt_pk_bf16(x[4], x[5]); w.w = cvt_pk_bf16(x[6], x[7]);
                      *(u32x4*)(t.dst + (size_t)(t.j0 + jj) * t.dst_ld + t.k0 + kb) = w; } } }
            __syncthreads();
            t = tn; job = nxt;
        }
    }
    bf16_t* U = (bf16_t*)(p.ws + WS_U);
    const int lane = tid & 63, gw = bid * 8 + (tid >> 6), nw = G * 8;
#define P0_ROWSRC(mm) ((const f32x4*)((mm) < NREAL ? p.x + (size_t)(mm) * DM : p.meta + (size_t)(((mm) - NREAL) & 15) * DM))
    f32x4 v[8];
#pragma unroll
    for (int i = 0; i < 8; ++i) v[i] = (f32x4){0.f, 0.f, 0.f, 0.f};
    if (gw < TOK) { const f32x4* src = P0_ROWSRC(gw);
#pragma unroll
        for (int i = 0; i < 8; ++i) v[i] = src[i * 64 + lane]; }
    for (int m = gw; m < MP; m += nw) {
        const int mn = m + nw; f32x4 vn[8];
#pragma unroll
        for (int i = 0; i < 8; ++i) vn[i] = (f32x4){0.f, 0.f, 0.f, 0.f};
        if (mn < TOK) { const f32x4* srcn = P0_ROWSRC(mn);
#pragma unroll
            for (int i = 0; i < 8; ++i) vn[i] = srcn[i * 64 + lane]; }
        u32x2* dst = (u32x2*)(U + (size_t)m * DM);
        if (m >= TOK) {
#pragma unroll
            for (int i = 0; i < 8; ++i) dst[i * 64 + lane] = (u32x2){0u, 0u};
        } else {
            float ss = 0.f;
#pragma unroll
            for (int i = 0; i < 8; ++i) ss += v[i][0] * v[i][0] + v[i][1] * v[i][1] + v[i][2] * v[i][2] + v[i][3] * v[i][3];
#pragma unroll
            for (int o = 32; o >= 1; o >>= 1) ss += __shfl_xor(ss, o);
            const float sc = rsqrtf(ss * (1.f / DM) + 1e-6f);
#pragma unroll
            for (int i = 0; i < 8; ++i) { const f32x4 nw4 = ((const f32x4*)p.norm_w)[i * 64 + lane];
                dst[i * 64 + lane] = (u32x2){cvt_pk_bf16(v[i][0] * sc * nw4[0], v[i][1] * sc * nw4[1]), cvt_pk_bf16(v[i][2] * sc * nw4[2], v[i][3] * sc * nw4[3])}; }
        }
#pragma unroll
        for (int i = 0; i < 8; ++i) v[i] = vn[i];
    }
#undef P0_ROWSRC
}

__device__ __forceinline__ void phase_final(const Params& p) {
    const float* rowss = (const float*)(p.ws + WS_ROWSS);
    const int tid = opaque_tid(), lane = tid & 63;
    const f32x4* fw4 = (const f32x4*)p.fnorm_w;
    f32x4 w[8];
#pragma unroll
    for (int i = 0; i < 8; ++i) w[i] = fw4[i * 64 + lane];
    for (int row = blockIdx.x * 8 + (tid >> 6); row < NREAL; row += gridDim.x * 8) {
        float ss = lane < 32 ? rowss[(size_t)row * 32 + lane] : 0.f;
#pragma unroll
        for (int o = 16; o >= 1; o >>= 1) ss += __shfl_xor(ss, o);
        ss = __shfl(ss, 0);
        const float sc = rsqrtf(ss * (1.f / DM) + 1e-6f);
        f32x4* o4 = (f32x4*)(p.out + (size_t)row * DM);
        f32x4 v[8];
#pragma unroll
        for (int i = 0; i < 8; ++i) v[i] = o4[i * 64 + lane];
#pragma unroll
        for (int i = 0; i < 8; ++i) { v[i][0] *= sc * w[i][0]; v[i][1] *= sc * w[i][1]; v[i][2] *= sc * w[i][2]; v[i][3] *= sc * w[i][3]; o4[i * 64 + lane] = v[i]; }
    }
}

#define XB_TMO      128
#define XB_XCNT(j)  (256  + 64 * (j))
#define XB_XSUB(j)  (1280 + 64 * (j))
#define XB_XGEN(j)  (2304 + 64 * (j))
#define XB_TOP      3328
#define XB_TOPGEN   3392
#define XCD_BAR_WORDS 3456
#define XB_SPIN_CAP (1u << 18)

__device__ __forceinline__ unsigned xb_ld(unsigned* p)              { return __hip_atomic_load(p, __ATOMIC_RELAXED, __HIP_MEMORY_SCOPE_AGENT); }
__device__ __forceinline__ unsigned xb_add(unsigned* p, unsigned v) { return __hip_atomic_fetch_add(p, v, __ATOMIC_RELAXED, __HIP_MEMORY_SCOPE_AGENT); }
__device__ __forceinline__ unsigned xb_xcc_id() { return (unsigned)__builtin_amdgcn_s_getreg((3 << 11) | 20) & 0xFu; }
#define XB_SPIN(cond, bar) do { unsigned _sp = 0; while (cond) { __builtin_amdgcn_s_sleep(1); \
    if ((++_sp & 255u) == 0u) { if (xb_ld(&(bar)[XB_TMO])) break; if (_sp > XB_SPIN_CAP) { atomicAdd(&(bar)[XB_TMO], 1u); break; } } } } while (0)

struct XcdBarrier {
    unsigned* bar; unsigned x;
    volatile LAS unsigned* st;
};

__device__ __forceinline__ XcdBarrier xcd_barrier_post(unsigned* bar, volatile LAS unsigned* st) {
    XcdBarrier b; b.bar = bar; b.x = xb_xcc_id(); b.st = st;
    if (threadIdx.x == 0) (void)xb_add(&bar[XB_XCNT(b.x)], 1u);
    return b;
}
__device__ __forceinline__ void xcd_barrier_complete(unsigned* bar, unsigned x, unsigned& nloc, unsigned& nx) {
    const unsigned G = gridDim.x * gridDim.y * gridDim.z;
    unsigned sum, cnt, mine, sp = 0u;
    for (;;) {
        sum = 0u; cnt = 0u; mine = 0u;
#pragma unroll
        for (unsigned j = 0; j < 16; ++j) { const unsigned c = xb_ld(&bar[XB_XCNT(j)]); sum += c; cnt += (c > 0u) ? 1u : 0u; mine = (j == x) ? c : mine; }
        if (sum == G) break;
        __builtin_amdgcn_s_sleep(1);
        if ((++sp & 255u) == 0u) { if (xb_ld(&bar[XB_TMO])) break; if (sp > XB_SPIN_CAP) { atomicAdd(&bar[XB_TMO], 1u); break; } }
    }
    nloc = mine > 0u ? mine : 1u; nx = cnt > 0u ? cnt : 1u;
}

__device__ __forceinline__ void xcd_barrier(const XcdBarrier& b) {
    asm volatile("s_waitcnt vmcnt(0)" ::: "memory");
    __syncthreads();
    if (threadIdx.x == 0) {
        unsigned* bar = b.bar;
        __builtin_amdgcn_s_waitcnt(0);
        unsigned nloc = b.st[0], nx = b.st[1];
        if (nloc == 0u) { xcd_barrier_complete(bar, b.x, nloc, nx); b.st[0] = nloc; b.st[1] = nx; }
        const unsigned old = xb_add(&bar[XB_XSUB(b.x)], 1u);
        const unsigned gen = old / nloc;
        if (old + 1u == (gen + 1u) * nloc) {
            __builtin_amdgcn_fence(__ATOMIC_RELEASE, "agent");
            asm volatile("s_waitcnt vmcnt(0)" ::: "memory");
            const unsigned og = xb_add(&bar[XB_TOP], 1u);
            const unsigned tg = og / nx;
            if (og + 1u == (tg + 1u) * nx) xb_add(&bar[XB_TOPGEN], 1u);
            else XB_SPIN(xb_ld(&bar[XB_TOPGEN]) == tg, bar);
            __builtin_amdgcn_fence(__ATOMIC_ACQUIRE, "agent");
            xb_add(&bar[XB_XGEN(b.x)], 1u);
            asm volatile("s_waitcnt vmcnt(0)" ::: "memory");
        } else {
            XB_SPIN(xb_ld(&bar[XB_XGEN(b.x)]) == gen, bar);
            __builtin_amdgcn_fence(__ATOMIC_ACQUIRE, "agent");
            asm volatile("s_waitcnt vmcnt(0)" ::: "memory");
        }
    }
    __syncthreads();
}


__device__ __forceinline__ void inverse64(float* Af, float* Zf, unsigned char* Tb, int tid) {
    const int lane = tid & 63, wave = tid >> 6;
    const int l15 = lane & 15, quad = lane >> 4;
    if (wave < 4) {
        const int o = wave * 16, col = l15;
        float t[16]; int roff = 0;
#pragma unroll
        for (int i = 0; i < 16; ++i) {
            if ((i & 1) == 0 && i >= 2) asm volatile("" : "+v"(roff) : "v"(t[i - 2]));
            float a0 = (i == col) ? 1.f : 0.f, a1 = 0.f, a2 = 0.f, a3 = 0.f;
#pragma unroll
            for (int j4 = 0; j4 < (i + 3) / 4; ++j4) { const f32x4 mv = *(const f32x4*)(Af + roff + (o + i) * 64 + o + j4 * 4);
                if (j4 * 4 + 0 < i) a0 -= mv[0] * t[j4 * 4 + 0];
                if (j4 * 4 + 1 < i) a1 -= mv[1] * t[j4 * 4 + 1];
                if (j4 * 4 + 2 < i) a2 -= mv[2] * t[j4 * 4 + 2];
                if (j4 * 4 + 3 < i) a3 -= mv[3] * t[j4 * 4 + 3]; }
            t[i] = (a0 + a1) + (a2 + a3);
        }
        asm volatile("s_waitcnt lgkmcnt(0)" ::: "memory");
        if (lane < 16) {
#pragma unroll
            for (int i = 0; i < 16; ++i) Af[(o + i) * 64 + o + col] = t[i]; }
    }
    __syncthreads();
    if (wave < 2) {
        const int o = wave * 32; f32x4 acc = {0.f, 0.f, 0.f, 0.f}, accb = {0.f, 0.f, 0.f, 0.f};
#pragma unroll
        for (int ks = 0; ks < 4; ++ks) { if (ks & 1) accb = __builtin_amdgcn_mfma_f32_16x16x4f32(Af[(o + 16 + l15) * 64 + o + ks * 4 + quad], Af[(o + ks * 4 + quad) * 64 + o + l15], accb, 0, 0, 0); else acc = __builtin_amdgcn_mfma_f32_16x16x4f32(Af[(o + 16 + l15) * 64 + o + ks * 4 + quad], Af[(o + ks * 4 + quad) * 64 + o + l15], acc, 0, 0, 0); }
        acc = acc + accb; accb = (f32x4){0.f, 0.f, 0.f, 0.f};
#pragma unroll
        for (int j = 0; j < 4; ++j) Zf[wave * 256 + (quad * 4 + j) * 16 + l15] = acc[j];
        asm volatile("s_waitcnt lgkmcnt(0)" ::: "memory");
        acc = (f32x4){0.f, 0.f, 0.f, 0.f};
#pragma unroll
        for (int ks = 0; ks < 4; ++ks) { if (ks & 1) accb = __builtin_amdgcn_mfma_f32_16x16x4f32(Af[(o + 16 + l15) * 64 + o + 16 + ks * 4 + quad], Zf[wave * 256 + (ks * 4 + quad) * 16 + l15], accb, 0, 0, 0); else acc = __builtin_amdgcn_mfma_f32_16x16x4f32(Af[(o + 16 + l15) * 64 + o + 16 + ks * 4 + quad], Zf[wave * 256 + (ks * 4 + quad) * 16 + l15], acc, 0, 0, 0); }
        acc = acc + accb; accb = (f32x4){0.f, 0.f, 0.f, 0.f};
#pragma unroll
        for (int j = 0; j < 4; ++j) Af[(o + 16 + quad * 4 + j) * 64 + o + l15] = -acc[j];
    }
    __syncthreads();
    const int ti = (wave >> 1) & 1, tj = wave & 1;
    if (wave < 4) {
        f32x4 acc = {0.f, 0.f, 0.f, 0.f}, accb = {0.f, 0.f, 0.f, 0.f};
#pragma unroll
        for (int ks = 0; ks < 8; ++ks) { if (ks & 1) accb = __builtin_amdgcn_mfma_f32_16x16x4f32(Af[(32 + ti * 16 + l15) * 64 + ks * 4 + quad], Af[(ks * 4 + quad) * 64 + tj * 16 + l15], accb, 0, 0, 0); else acc = __builtin_amdgcn_mfma_f32_16x16x4f32(Af[(32 + ti * 16 + l15) * 64 + ks * 4 + quad], Af[(ks * 4 + quad) * 64 + tj * 16 + l15], acc, 0, 0, 0); }
        acc = acc + accb; accb = (f32x4){0.f, 0.f, 0.f, 0.f};
#pragma unroll
        for (int j = 0; j < 4; ++j) Zf[(ti * 16 + quad * 4 + j) * 32 + tj * 16 + l15] = acc[j];
    }
    __syncthreads();
    if (wave < 4) {
        f32x4 acc = {0.f, 0.f, 0.f, 0.f}, accb = {0.f, 0.f, 0.f, 0.f};
#pragma unroll
        for (int ks = 0; ks < 8; ++ks) { if (ks & 1) accb = __builtin_amdgcn_mfma_f32_16x16x4f32(Af[(32 + ti * 16 + l15) * 64 + 32 + ks * 4 + quad], Zf[(ks * 4 + quad) * 32 + tj * 16 + l15], accb, 0, 0, 0); else acc = __builtin_amdgcn_mfma_f32_16x16x4f32(Af[(32 + ti * 16 + l15) * 64 + 32 + ks * 4 + quad], Zf[(ks * 4 + quad) * 32 + tj * 16 + l15], acc, 0, 0, 0); }
        acc = acc + accb; accb = (f32x4){0.f, 0.f, 0.f, 0.f};
#pragma unroll
        for (int j = 0; j < 4; ++j) Af[(32 + ti * 16 + quad * 4 + j) * 64 + tj * 16 + l15] = -acc[j];
    }
    __syncthreads();
    {   const int row = tid >> 3, c0 = (tid & 7) * 8;
        const f32x4 v0 = *(const f32x4*)(Af + row * 64 + c0), v1 = *(const f32x4*)(Af + row * 64 + c0 + 4);
        u32x4 w; w.x = cvt_pk_bf16(v0[0], v0[1]); w.y = cvt_pk_bf16(v0[2], v0[3]); w.z = cvt_pk_bf16(v1[0], v1[1]); w.w = cvt_pk_bf16(v1[2], v1[3]);
        *(u32x4*)(Tb + (row * 72 + c0) * 2) = w; }
    __syncthreads();
}
__device__ __forceinline__ bf16x8 gather8c(const unsigned char* base, int ld, int r0, int c0, int l15, int quad) {
    const int lo = (quad * 8 * ld + l15) * 2;
    bf16x8 g;
#pragma unroll
    for (int i = 0; i < 8; ++i) g[i] = *(const short*)(base + lo + ((r0 + i) * ld + c0) * 2);
    return g;
}

struct DnIn { u32x4 x[11]; float bb, aa; };
__device__ __forceinline__ void dn_load(const Params& p, int job, DnIn& in, int tid) {
    const bf16_t* P = (const bf16_t*)(p.ws + WS_P);
    const int bh = job / NCH, n = job % NCH, b = bh >> 3, h = bh & 7;
    in.bb = 0.f; in.aa = 0.f;
    if (tid < 64) { const int tp = n * 64 + tid - 48;
        if (tp >= 0) { const size_t m = (size_t)rowof(b, tp) * NP; in.bb = bf2f(P[m + C_DB + h]); in.aa = bf2f(P[m + C_DA + h]); } }
    const int grp = tid >> 4, g8 = tid & 15;
#pragma unroll
    for (int i = 0; i < 11; ++i) in.x[i] = (u32x4){0u, 0u, 0u, 0u};
    if (grp < 24) { const int which = grp >> 3, c0 = (grp & 7) * 8, chn = which * 1024 + h * 128 + g8 * 8, tp0 = n * 64 + c0 - 48;
#pragma unroll
        for (int i = 0; i < 11; ++i) { const int tpi = tp0 - 3 + i; if (tpi >= 0) in.x[i] = *(const u32x4*)(P + (size_t)rowof(b, tpi) * NP + C_DQ + chn); } }
}
__device__ __forceinline__ void dn_prep(const Params& p, int job, unsigned char* lds, DnIn& in, int next_job) {
    const int bh = job / NCH, n = job % NCH, b = bh >> 3, h = bh & 7;
    const int tid = opaque_tid(), lane = tid & 63, wave = tid >> 6, l15 = lane & 15, quad = lane >> 4;
    const bf16_t* P = (const bf16_t*)(p.ws + WS_P);
    unsigned char* blk = p.ws + WS_DNP + (size_t)job * DNP_BLK;
    bf16_t* gW = (bf16_t*)blk; bf16_t* gQG = (bf16_t*)(blk + 16384); bf16_t* gKDT = (bf16_t*)(blk + 32768); bf16_t* gAT = (bf16_t*)(blk + 49152); bf16_t* gU = (bf16_t*)(blk + 57344);
    unsigned char* Kn = lds; unsigned char* Kb = lds + 17408; unsigned char* Qs = lds + 34816; unsigned char* Vb = lds + 52224; unsigned char* Kbg = lds + 69632; unsigned char* Kd = lds + 87040;
    float* Mf = (float*)(lds + 104448); unsigned char* Tb = lds + 120832; float* Gs = (float*)(lds + 130048);
    if (tid < 64) {
        const int tp = n * 64 + tid - 48; float gl = 0.f, bt = 0.f;
        if (tp >= 0) { bt = sigmoidf_(in.bb); gl = -__expf(p.A_log[h]) * softplusf_(in.aa + p.dt_bias[h]); }
#pragma unroll
        for (int off = 1; off < 64; off <<= 1) { const float t = __shfl_up(gl, off); if (lane >= off) gl += t; }
        Gs[tid] = gl; Gs[64 + tid] = bt;
    }
    __syncthreads();
    const float glast = Gs[63];
    if (tid == 0) ((float*)(p.ws + WS_DNG))[job] = __expf(glast);
    {
        const int grp = tid >> 4, g8 = tid & 15;
        if (grp < 24) {
            const int which = grp >> 3, c0 = (grp & 7) * 8, chn = which * 1024 + h * 128 + g8 * 8, tp0 = n * 64 + c0 - 48;
            f32x4 cw[4][2];
#pragma unroll
            for (int i = 0; i < 4; ++i) { cw[i][0] = *(const f32x4*)(p.conv_w + (size_t)i * 3072 + chn); cw[i][1] = *(const f32x4*)(p.conv_w + (size_t)i * 3072 + chn + 4); }
#pragma unroll
            for (int cc = 0; cc < 8; ++cc) {
                const int c = c0 + cc; float acc[8];
#pragma unroll
                for (int e = 0; e < 8; ++e) acc[e] = 0.f;
#pragma unroll
                for (int i = 0; i < 4; ++i) { const u32x4 xv = in.x[cc + i];
                    acc[0] += cw[i][0][0] * bf_lo(xv.x); acc[1] += cw[i][0][1] * bf_hi(xv.x); acc[2] += cw[i][0][2] * bf_lo(xv.y); acc[3] += cw[i][0][3] * bf_hi(xv.y);
                    acc[4] += cw[i][1][0] * bf_lo(xv.z); acc[5] += cw[i][1][1] * bf_hi(xv.z); acc[6] += cw[i][1][2] * bf_lo(xv.w); acc[7] += cw[i][1][3] * bf_hi(xv.w); }
                if (tp0 >= 0) {
#pragma unroll
                    for (int e = 0; e < 8; ++e) acc[e] = siluf_(acc[e]); }
                else {
#pragma unroll
                    for (int e = 0; e < 8; ++e) acc[e] = 0.f; }
                float ss = 0.f;
#pragma unroll
                for (int e = 0; e < 8; ++e) ss += acc[e] * acc[e];
                ss = sum16(ss);
                const float inv = rsqrtf(ss + 1e-6f);
                const float gc = Gs[c], bt = Gs[64 + c];
                const int lo = (c * 136 + g8 * 8) * 2;
#define PK8(dstp, sc) do { const float _s = (sc); u32x4 _w; _w.x = cvt_pk_bf16(acc[0] * _s, acc[1] * _s); _w.y = cvt_pk_bf16(acc[2] * _s, acc[3] * _s); \
        _w.z = cvt_pk_bf16(acc[4] * _s, acc[5] * _s); _w.w = cvt_pk_bf16(acc[6] * _s, acc[7] * _s); *(u32x4*)(dstp) = _w; } while (0)
                if (which == 0) { const float sc = inv * 0.08838834764831845f; PK8(Qs + lo, sc); PK8(gQG + c * 128 + g8 * 8, sc * __expf(gc)); }
                else if (which == 1) { PK8(Kn + lo, inv); PK8(Kb + lo, inv * bt); PK8(Kbg + lo, inv * bt * __expf(gc)); PK8(Kd + lo, inv * __expf(glast - gc)); }
                else { PK8(Vb + lo, bt); }
#undef PK8
            }
        }
    }
    if (next_job >= 0) dn_load(p, next_job, in, tid);
    __syncthreads();
#pragma unroll 1
    for (int i = 0; i < 4; ++i) {
        const int tile = wave * 4 + i;
        f32x4 acc = {0.f, 0.f, 0.f, 0.f};
        if (tile < 16) { const int ct = tile >> 2, st = tile & 3;
            bf16x8 fa[4], fb[4]; f32x4 acc2 = {0.f, 0.f, 0.f, 0.f};
#pragma unroll
            for (int ks = 0; ks < 4; ++ks) { fa[ks] = ldfrag(Kb, 136, ct * 16, ks * 32, lane); fb[ks] = ldfrag(Kn, 136, st * 16, ks * 32, lane); }
            acc = MFMA16(fa[0], fb[0], acc); acc2 = MFMA16(fa[1], fb[1], acc2); acc = MFMA16(fa[2], fb[2], acc); acc2 = MFMA16(fa[3], fb[3], acc2);
            acc = acc + acc2;
            const int s = st * 16 + l15; const float gs = Gs[s];
#pragma unroll
            for (int j = 0; j < 4; ++j) { const int c = ct * 16 + quad * 4 + j; Mf[c * 64 + s] = (s < c) ? acc[j] * __expf(Gs[c] - gs) : 0.f; }
        } else { const int t2 = tile - 16, st = t2 >> 2, ct = t2 & 3;
            bf16x8 fa[4], fb[4]; f32x4 acc2 = {0.f, 0.f, 0.f, 0.f};
#pragma unroll
            for (int ks = 0; ks < 4; ++ks) { fa[ks] = ldfrag(Kn, 136, st * 16, ks * 32, lane); fb[ks] = ldfrag(Qs, 136, ct * 16, ks * 32, lane); }
            acc = MFMA16(fa[0], fb[0], acc); acc2 = MFMA16(fa[1], fb[1], acc2); acc = MFMA16(fa[2], fb[2], acc); acc2 = MFMA16(fa[3], fb[3], acc2);
            acc = acc + acc2;
            const int c = ct * 16 + l15; const float gc = Gs[c]; float v[4];
#pragma unroll
            for (int j = 0; j < 4; ++j) { const int s = st * 16 + quad * 4 + j; v[j] = (s <= c) ? acc[j] * __expf(gc - Gs[s]) : 0.f; }
            *(u32x2*)(gAT + c * 64 + st * 16 + quad * 4) = (u32x2){cvt_pk_bf16(v[0], v[1]), cvt_pk_bf16(v[2], v[3])};
        }
    }
    __syncthreads();
    inverse64(Mf, (float*)(lds + 130560), Tb, tid);
    {
        const int dt = wave;
        bf16x8 GV[2], GK[2];
#pragma unroll
        for (int ks = 0; ks < 2; ++ks)
#pragma unroll
            for (int i = 0; i < 8; ++i) { const int lo = (quad * 8 * 136 + dt * 16 + l15) * 2, off = (ks * 32 + i) * 136 * 2;
                GV[ks][i] = *(const short*)(Vb + lo + off); GK[ks][i] = *(const short*)(Kbg + lo + off); }
        bf16x8 tfr[4][2]; f32x4 aus[4], aws[4];
#pragma unroll
        for (int ct = 0; ct < 4; ++ct) { tfr[ct][0] = ldfrag(Tb, 72, ct * 16, 0, lane); tfr[ct][1] = ldfrag(Tb, 72, ct * 16, 32, lane); }
#pragma unroll
        for (int ct = 0; ct < 4; ++ct) { aus[ct] = MFMA16(tfr[ct][0], GV[0], ((f32x4){0.f, 0.f, 0.f, 0.f})); aws[ct] = MFMA16(GK[0], tfr[ct][0], ((f32x4){0.f, 0.f, 0.f, 0.f})); }
#pragma unroll
        for (int ct = 0; ct < 4; ++ct) { aus[ct] = MFMA16(tfr[ct][1], GV[1], aus[ct]); aws[ct] = MFMA16(GK[1], tfr[ct][1], aws[ct]); }
#pragma unroll
        for (int ct = 0; ct < 4; ++ct) {
            const f32x4 au = aus[ct], aw = aws[ct];
            *(u32x2*)(gU + ((ct * 8 + dt) * 64 + lane) * 4) = (u32x2){cvt_pk_bf16(au[0], au[1]), cvt_pk_bf16(au[2], au[3])};
            *(u32x2*)(gW + (ct * 16 + l15) * 128 + dt * 16 + quad * 4) = (u32x2){cvt_pk_bf16(-aw[0], -aw[1]), cvt_pk_bf16(-aw[2], -aw[3])};
        }
        const int k = tid & 127, cbq = tid >> 7;
#pragma unroll
        for (int rr = 0; rr < 2; ++rr) { const int cb = cbq + rr * 4; unsigned v[8];
#pragma unroll
            for (int i = 0; i < 8; ++i) v[i] = *(const bf16_t*)(Kd + ((cb * 8 + i) * 136 + k) * 2);
            u32x4 w; w.x = v[0] | (v[1] << 16); w.y = v[2] | (v[3] << 16); w.z = v[4] | (v[5] << 16); w.w = v[6] | (v[7] << 16);
            *(u32x4*)(gKDT + k * 64 + cb * 8) = w; }
    }
    __syncthreads();
}

constexpr int DN_PARTS = 4, DN_VPW = 8 / DN_PARTS;
constexpr size_t DN_ORAW_OFF = (size_t)64 << 20;
__device__ __forceinline__ void dn_scan(const Params& p, int bh, int part, unsigned char* lds) {
    const int b = bh >> 3, h = bh & 7, tid = opaque_tid(), lane = tid & 63, wave = tid >> 6, l15 = lane & 15, quad = lane >> 4;
    const bool mf = wave < DN_VPW; const int vt = part * DN_VPW + (wave & (DN_VPW - 1));
    (void)b; (void)h;
    const float* DNG = (const float*)(p.ws + WS_DNG) + bh * NCH;
    unsigned char* Wl = lds; unsigned char* QGl = lds + 17408; unsigned char* KDl = lds + 34816; unsigned char* ATl = lds + 53248;
    unsigned char* St = lds + 62464 + (wave & (DN_VPW - 1)) * 4352; unsigned char* Vt = lds + 97280 + (wave & (DN_VPW - 1)) * 2304;
    f32x4 S[8];
#pragma unroll
    for (int i = 0; i < 8; ++i) S[i] = (f32x4){0.f, 0.f, 0.f, 0.f};
    u32x4 pw[2], pq[2], pk[2], pa; u32x2 pu[4];
#define DN_PREFETCH(nn) do { const unsigned char* blk_ = p.ws + WS_DNP + (size_t)(bh * NCH + (nn)) * DNP_BLK; \
        _Pragma("unroll") for (int i_ = 0; i_ < 2; ++i_) { const int id_ = tid + 512 * i_; pw[i_] = *(const u32x4*)(blk_ + id_ * 16); pq[i_] = *(const u32x4*)(blk_ + 16384 + id_ * 16); pk[i_] = *(const u32x4*)(blk_ + 32768 + id_ * 16); } \
        pa = *(const u32x4*)(blk_ + 49152 + tid * 16); \
        _Pragma("unroll") for (int ct_ = 0; ct_ < 4; ++ct_) pu[ct_] = *(const u32x2*)(blk_ + 57344 + (((ct_ * 8 + vt) * 64 + lane) * 8)); } while (0)
    DN_PREFETCH(0);
#pragma unroll 1
    for (int n = 0; n < NCH; ++n) {
        __syncthreads();
#pragma unroll
        for (int i = 0; i < 2; ++i) { const int id = tid + 512 * i;
            *(u32x4*)(Wl + ((id >> 4) * 136 + (id & 15) * 8) * 2) = pw[i]; *(u32x4*)(QGl + ((id >> 4) * 136 + (id & 15) * 8) * 2) = pq[i];
            *(u32x4*)(KDl + ((id >> 3) * 72 + (id & 7) * 8) * 2) = pk[i]; }
        *(u32x4*)(ATl + ((tid >> 3) * 72 + (tid & 7) * 8) * 2) = pa;
        f32x4 vn[4];
#pragma unroll
        for (int ct = 0; ct < 4; ++ct) vn[ct] = (f32x4){bf_lo(pu[ct].x), bf_hi(pu[ct].x), bf_lo(pu[ct].y), bf_hi(pu[ct].y)};
        const float dec = DNG[n];
        __syncthreads();
        if (n + 1 < NCH) DN_PREFETCH(n + 1);
        unsigned char* ogl = (unsigned char*)p.out + DN_ORAW_OFF + (size_t)(bh * NCH + n) * 16384;
        if (mf) {
#pragma unroll
        for (int kt = 0; kt < 8; ++kt) *(u32x2*)(St + (l15 * 136 + kt * 16 + quad * 4) * 2) = (u32x2){cvt_pk_bf16(S[kt][0], S[kt][1]), cvt_pk_bf16(S[kt][2], S[kt][3])};
        asm volatile("s_waitcnt lgkmcnt(0)" ::: "memory");
        bf16x8 sf[4];
#pragma unroll
        for (int ks = 0; ks < 4; ++ks) sf[ks] = ldfrag(St, 136, 0, ks * 32, lane);
        {   bf16x8 fa[4], fb[4];
#pragma unroll
            for (int ct = 0; ct < 4; ++ct) fa[ct] = ldfrag(Wl, 136, ct * 16, 0, lane);
#pragma unroll
            for (int ks = 0; ks < 4; ++ks) {
                if (ks + 1 < 4) {
#pragma unroll
                    for (int ct = 0; ct < 4; ++ct) { if (ks & 1) fa[ct] = ldfrag(Wl, 136, ct * 16, (ks + 1) * 32, lane); else fb[ct] = ldfrag(Wl, 136, ct * 16, (ks + 1) * 32, lane); } }
#pragma unroll
                for (int ct = 0; ct < 4; ++ct) vn[ct] = MFMA16((ks & 1) ? fb[ct] : fa[ct], sf[ks], vn[ct]);
            } }
#pragma unroll
        for (int ct = 0; ct < 4; ++ct) *(u32x2*)(Vt + (l15 * 72 + ct * 16 + quad * 4) * 2) = (u32x2){cvt_pk_bf16(vn[ct][0], vn[ct][1]), cvt_pk_bf16(vn[ct][2], vn[ct][3])};
        asm volatile("s_waitcnt lgkmcnt(0)" ::: "memory");
        bf16x8 vf[2];
#pragma unroll
        for (int ks = 0; ks < 2; ++ks) vf[ks] = ldfrag(Vt, 72, 0, ks * 32, lane);
        {   f32x4 o[4]; bf16x8 fa[4], fb[4];
#pragma unroll
            for (int ct = 0; ct < 4; ++ct) { o[ct] = (f32x4){0.f, 0.f, 0.f, 0.f}; fa[ct] = ldfrag(QGl, 136, ct * 16, 0, lane); }
#pragma unroll
            for (int ks = 0; ks < 6; ++ks) {
                if (ks + 1 < 6) {
#pragma unroll
                    for (int ct = 0; ct < 4; ++ct) { const bf16x8 f = (ks + 1 < 4) ? ldfrag(QGl, 136, ct * 16, (ks + 1) * 32, lane) : ldfrag(ATl, 72, ct * 16, (ks + 1 - 4) * 32, lane);
                        if (ks & 1) fa[ct] = f; else fb[ct] = f; } }
#pragma unroll
                for (int ct = 0; ct < 4; ++ct) o[ct] = MFMA16(ks < 4 ? sf[ks] : vf[ks - 4], (ks & 1) ? fb[ct] : fa[ct], o[ct]);
            }
#pragma unroll
            for (int ct = 0; ct < 4; ++ct)
                *(u32x2*)(ogl + ((ct * 16 + l15) * 128 + vt * 16 + quad * 4) * 2) = (u32x2){cvt_pk_bf16(o[ct][0], o[ct][1]), cvt_pk_bf16(o[ct][2], o[ct][3])}; }
        {   bf16x8 fa[8], fb[8];
#pragma unroll
            for (int kt = 0; kt < 8; ++kt) { fa[kt] = ldfrag(KDl, 72, kt * 16, 0, lane); S[kt] = S[kt] * dec; }
#pragma unroll
            for (int kt = 0; kt < 8; ++kt) fb[kt] = ldfrag(KDl, 72, kt * 16, 32, lane);
#pragma unroll
            for (int kt = 0; kt < 8; ++kt) S[kt] = MFMA16(fa[kt], vf[0], S[kt]);
#pragma unroll
            for (int kt = 0; kt < 8; ++kt) S[kt] = MFMA16(fb[kt], vf[1], S[kt]);
        }
        }
    }
#undef DN_PREFETCH
}


struct DnPostIn { u32x4 o0, o1, z0, z1; };
__device__ __forceinline__ void dn_post_load(const Params& p, int job, DnPostIn& in, int tid) {
    const int bh = job / NCH, n = job % NCH, b = bh >> 3, h = bh & 7;
    const int pc = tid >> 3, pvg = tid & 7, tp = n * 64 + pc - 48;
    const bf16_t* P = (const bf16_t*)(p.ws + WS_P);
    const unsigned char* op = (const unsigned char*)p.out + DN_ORAW_OFF + (size_t)job * 16384 + (pc * 128 + pvg * 16) * 2;
    const bf16_t* zp = P + (size_t)rowof(b, tp < 0 ? 0 : tp) * NP + C_Z + h * 128 + pvg * 16;
    in.o0 = ((const u32x4*)op)[0]; in.o1 = ((const u32x4*)op)[1]; in.z0 = ((const u32x4*)zp)[0]; in.z1 = ((const u32x4*)zp)[1];
}
__device__ __forceinline__ void dn_post(const Params& p, int job, const DnPostIn& in, int tid) {
    const int bh = job / NCH, n = job % NCH, b = bh >> 3, h = bh & 7;
    const int pc = tid >> 3, pvg = tid & 7, tp = n * 64 + pc - 48;
    bf16_t* P = (bf16_t*)(p.ws + WS_P);
    const bool valid = tp >= 0;
    bf16_t* zp = P + (size_t)rowof(b, valid ? tp : 0) * NP + C_Z + h * 128 + pvg * 16;
    const u32x4 o0 = in.o0, o1 = in.o1, z0 = in.z0, z1 = in.z1;
    const f32x4 nw0 = *(const f32x4*)(p.dn_norm_w + pvg * 16), nw1 = *(const f32x4*)(p.dn_norm_w + pvg * 16 + 4), nw2 = *(const f32x4*)(p.dn_norm_w + pvg * 16 + 8), nw3 = *(const f32x4*)(p.dn_norm_w + pvg * 16 + 12);
    const float nw[16] = {nw0[0], nw0[1], nw0[2], nw0[3], nw1[0], nw1[1], nw1[2], nw1[3], nw2[0], nw2[1], nw2[2], nw2[3], nw3[0], nw3[1], nw3[2], nw3[3]};
    float ov[16], zv[16];
#pragma unroll
    for (int e = 0; e < 4; ++e) { ov[2 * e] = bf_lo(o0[e]); ov[2 * e + 1] = bf_hi(o0[e]); ov[8 + 2 * e] = bf_lo(o1[e]); ov[8 + 2 * e + 1] = bf_hi(o1[e]);
        zv[2 * e] = bf_lo(z0[e]); zv[2 * e + 1] = bf_hi(z0[e]); zv[8 + 2 * e] = bf_lo(z1[e]); zv[8 + 2 * e + 1] = bf_hi(z1[e]); }
    float ss = 0.f;
#pragma unroll
    for (int e = 0; e < 16; ++e) ss += ov[e] * ov[e];
    ss = sum8(ss);
    const float inv = rsqrtf(ss * (1.f / 128.f) + 1e-6f);
    float r[16];
#pragma unroll
    for (int e = 0; e < 16; ++e) r[e] = ov[e] * inv * nw[e] * siluf_(zv[e]);
    if (valid) { u32x4 w0, w1;
        w0.x = cvt_pk_bf16(r[0], r[1]); w0.y = cvt_pk_bf16(r[2], r[3]); w0.z = cvt_pk_bf16(r[4], r[5]); w0.w = cvt_pk_bf16(r[6], r[7]);
        w1.x = cvt_pk_bf16(r[8], r[9]); w1.y = cvt_pk_bf16(r[10], r[11]); w1.z = cvt_pk_bf16(r[12], r[13]); w1.w = cvt_pk_bf16(r[14], r[15]);
        ((u32x4*)zp)[0] = w0; ((u32x4*)zp)[1] = w1; }
}

constexpr size_t RWP_BLK = 33792;
constexpr int RWP_SPLIT = 2296;
__device__ __forceinline__ unsigned char* rwp_ptr(const Params& p, int job) {
    return job < RWP_SPLIT ? p.ws + WS_RWP + (size_t)job * RWP_BLK : (unsigned char*)p.out + (size_t)(job - RWP_SPLIT) * RWP_BLK;
}
#define PACK4(a) ((u32x2){cvt_pk_bf16((a)[0], (a)[1]), cvt_pk_bf16((a)[2], (a)[3])})


struct RwIn { u32x4 lc[2], lq[2], cr, ck, cv, qr, qk, qv; bf16x8 A1[2], A2[2]; f32x4 w0v, a0v; f32x4 mul[4]; };
__device__ __forceinline__ void rw_load(const Params& p, int job, RwIn& in, int tid) {
    const bf16_t* P = (const bf16_t*)(p.ws + WS_P);
    const int bh = job / NCH, n = job % NCH, b = bh >> 4, h = bh & 15;
    const u32x4 z = {0u, 0u, 0u, 0u};
    in.lc[0] = z; in.lc[1] = z; in.lq[0] = z; in.lq[1] = z; in.cr = z; in.ck = z; in.cv = z; in.qr = z; in.qk = z; in.qv = z;
    const int tp = n * 64 + (tid >> 3) - 48, cs = (tid & 7) * 16, chn3 = h * 64 + (tid & 7) * 8;
    {
        const int lane = tid & 63, wave = tid >> 6, l15 = lane & 15, quad = lane >> 4, chl = (wave & 3) * 16;
        const bf16_t* W2T = (const bf16_t*)(p.ws + WS_W2T); const bf16_t* A2T = (const bf16_t*)(p.ws + WS_A2T);
#pragma unroll
        for (int ks = 0; ks < 2; ++ks) { in.A1[ks] = *(const bf16x8*)(W2T + (size_t)(h * 64 + chl + l15) * 64 + ks * 32 + quad * 8); in.A2[ks] = *(const bf16x8*)(A2T + (size_t)(h * 64 + chl + l15) * 64 + ks * 32 + quad * 8); }
        const int ch = h * 64 + chl + quad * 4;
        in.w0v = *(const f32x4*)(p.w0 + ch); in.a0v = *(const f32x4*)(p.a0 + ch);
    }
    if (tp >= 0) {
        const bf16_t* rp = P + (size_t)rowof(b, tp) * NP;
        in.lc[0] = *(const u32x4*)(rp + C_LW + cs); in.lc[1] = *(const u32x4*)(rp + C_LW + cs + 8);
        in.cr = *(const u32x4*)(rp + chn3 + C_R); in.ck = *(const u32x4*)(rp + chn3 + C_K); in.cv = *(const u32x4*)(rp + chn3 + C_V);
        if (tp > 0) { const bf16_t* pp = P + (size_t)rowof(b, tp - 1) * NP;
            in.lq[0] = *(const u32x4*)(pp + C_LW + cs); in.lq[1] = *(const u32x4*)(pp + C_LW + cs + 8);
            in.qr = *(const u32x4*)(pp + chn3 + C_R); in.qk = *(const u32x4*)(pp + chn3 + C_K); in.qv = *(const u32x4*)(pp + chn3 + C_V); } }
}
__device__ __forceinline__ void rw_prep(const Params& p, int job, unsigned char* lds, RwIn& in, int next_job) {
    const int bh = job / NCH, n = job % NCH, b = bh >> 4, h = bh & 15;
    const int tid = opaque_tid(), lane = tid & 63, wave = tid >> 6, l15 = lane & 15, quad = lane >> 4;
    const bf16_t* P = (const bf16_t*)(p.ws + WS_P);
    unsigned char* blk = rwp_ptr(p, job);
    bf16_t* gQ = (bf16_t*)blk; bf16_t* gF = (bf16_t*)(blk + 8192); bf16_t* gY0 = (bf16_t*)(blk + 16384); bf16_t* gS0 = (bf16_t*)(blk + 24576);
    float* gWC = (float*)(blk + 32768); float* gBS = (float*)(blk + 33024);
    unsigned char* sKap = lds; unsigned char* sBet = lds + 9216; unsigned char* sKti = lds + 18432; unsigned char* sRho = lds + 27648; unsigned char* sBd = lds + 36864;
    unsigned char* sKd = lds + 46080; unsigned char* sV = lds + 55296; unsigned char* sBm = lds + 64512; unsigned char* sAb = lds + 73728; unsigned char* sAk = lds + 82944; unsigned char* sT = lds + 92160;
    unsigned char* sP1 = sBet; unsigned char* sX = sKti; unsigned char* sP2 = sBm;
    float* Af = (float*)(lds + 101376);
    float* AA = (float*)(lds + 64512);
    float* Zf = (float*)(lds + 117760);
    unsigned char* X1 = lds + 121856; unsigned char* X2 = lds + 131072;
    float* WC = (float*)(lds + 140288);
    const int t3 = tid >> 3, c8 = (tid & 7) * 8, chn3 = h * 64 + c8;
    f32x4 cmr[2], cmk[2], cmv[2], ckk[2], cka[2], crk[2];
#pragma unroll
    for (int i = 0; i < 2; ++i) { cmr[i] = *(const f32x4*)(p.mu + C_R + chn3 + 4 * i); cmk[i] = *(const f32x4*)(p.mu + C_K + chn3 + 4 * i); cmv[i] = *(const f32x4*)(p.mu + C_V + chn3 + 4 * i);
        ckk[i] = *(const f32x4*)(p.k_k + chn3 + 4 * i); cka[i] = *(const f32x4*)(p.k_a + chn3 + 4 * i); crk[i] = *(const f32x4*)(p.r_k + chn3 + 4 * i); }
    {
        const int tok = tid >> 3, cs = (tid & 7) * 16;
        const u32x4 c[2] = {in.lc[0], in.lc[1]}, q[2] = {in.lq[0], in.lq[1]};
        float v[16];
#pragma unroll
        for (int i = 0; i < 2; ++i)
#pragma unroll
            for (int e = 0; e < 4; ++e) { const unsigned cw = c[i][e], qw = q[i][e];
                const float c0 = bf_lo(cw), c1 = bf_hi(cw), q0 = bf_lo(qw), q1 = bf_hi(qw);
                const int idx = i * 8 + e * 2; const float mu0 = in.mul[idx >> 2][idx & 3], mu1 = in.mul[(idx + 1) >> 2][(idx + 1) & 3];
                v[idx] = c0 + (q0 - c0) * mu0; v[idx + 1] = c1 + (q1 - c1) * mu1; }
        if (cs < 64) {
#pragma unroll
            for (int i = 0; i < 16; ++i) { const float e2 = __expf(2.f * v[i]); v[i] = 1.f - 2.f * __builtin_amdgcn_rcpf(e2 + 1.f); } }
        unsigned char* dst = (cs < 64 ? X1 : X2) + (tok * 72 + (cs & 63)) * 2;
        u32x4 w0, w1;
        w0.x = cvt_pk_bf16(v[0], v[1]); w0.y = cvt_pk_bf16(v[2], v[3]); w0.z = cvt_pk_bf16(v[4], v[5]); w0.w = cvt_pk_bf16(v[6], v[7]);
        w1.x = cvt_pk_bf16(v[8], v[9]); w1.y = cvt_pk_bf16(v[10], v[11]); w1.z = cvt_pk_bf16(v[12], v[13]); w1.w = cvt_pk_bf16(v[14], v[15]);
        ((u32x4*)dst)[0] = w0; ((u32x4*)dst)[1] = w1;
    }
    __syncthreads();
    {
        const int chl = (wave & 3) * 16, tt0 = (wave >> 2) * 2;
        const bf16x8 A1[2] = {in.A1[0], in.A1[1]}, A2[2] = {in.A2[0], in.A2[1]}; const f32x4 w0v = in.w0v, a0v = in.a0v;
        bf16x8 xf1[2][2], xf2[2][2];
#pragma unroll
        for (int q = 0; q < 2; ++q)
#pragma unroll
            for (int ks = 0; ks < 2; ++ks) { xf1[q][ks] = ldfrag(X1, 72, (tt0 + q) * 16, ks * 32, lane); xf2[q][ks] = ldfrag(X2, 72, (tt0 + q) * 16, ks * 32, lane); }
#pragma unroll
        for (int q = 0; q < 2; ++q) { const int tt = tt0 + q;
            f32x4 acc1 = {0.f, 0.f, 0.f, 0.f}, acc2 = {0.f, 0.f, 0.f, 0.f};
#pragma unroll
            for (int ks = 0; ks < 2; ++ks) { acc1 = MFMA16(A1[ks], xf1[q][ks], acc1); acc2 = MFMA16(A2[ks], xf2[q][ks], acc2); }
            const int tok = tt * 16 + l15; const bool nul = (n * 64 + tok - 48) < 0;
            f32x4 ew, av;
#pragma unroll
            for (int j = 0; j < 4; ++j) { ew[j] = nul ? 0.f : 0.6065306597f * sigmoidf_(w0v[j] + acc1[j]); av[j] = sigmoidf_(a0v[j] + acc2[j]); }
            *(f32x4*)(Af + tok * 64 + chl + quad * 4) = ew; *(f32x4*)(AA + tok * 64 + chl + quad * 4) = av;
        }
    }
    __syncthreads();
    {
        const int ch = tid & 63, seg = tid >> 6;
        float e[8], s = 0.f;
#pragma unroll
        for (int i = 0; i < 8; ++i) { e[i] = Af[(seg * 8 + i) * 64 + ch]; s += e[i]; }
        Zf[seg * 64 + ch] = s;
        __syncthreads();
        float pre = 0.f;
#pragma unroll
        for (int s2 = 0; s2 < 7; ++s2) pre += (s2 < seg) ? Zf[s2 * 64 + ch] : 0.f;
#pragma unroll
        for (int i = 0; i < 8; ++i) { pre += e[i]; Af[(seg * 8 + i) * 64 + ch] = -pre; }
        if (seg == 7) { const float wc = __expf(-pre); WC[ch] = wc; gWC[ch] = wc; }
    }
    __syncthreads();
    {
        const int t = t3;
        const u32x4 cr = in.cr, ck = in.ck, cv = in.cv, qr = in.qr, qk = in.qk, qv = in.qv;
        float r[8], k[8], v[8];
#pragma unroll
        for (int e = 0; e < 4; ++e) {
            const int i = e >> 1, j0 = (2 * e) & 3;
            float c0 = bf_lo(cr[e]), c1 = bf_hi(cr[e]); r[2 * e] = c0 + (bf_lo(qr[e]) - c0) * cmr[i][j0]; r[2 * e + 1] = c1 + (bf_hi(qr[e]) - c1) * cmr[i][j0 + 1];
            c0 = bf_lo(ck[e]); c1 = bf_hi(ck[e]); k[2 * e] = c0 + (bf_lo(qk[e]) - c0) * cmk[i][j0]; k[2 * e + 1] = c1 + (bf_hi(qk[e]) - c1) * cmk[i][j0 + 1];
            c0 = bf_lo(cv[e]); c1 = bf_hi(cv[e]); v[2 * e] = c0 + (bf_lo(qv[e]) - c0) * cmv[i][j0]; v[2 * e + 1] = c1 + (bf_hi(qv[e]) - c1) * cmv[i][j0 + 1]; }
        float kn[8], km[8], bb[8], ss = 0.f, bs = 0.f;
#pragma unroll
        for (int e = 0; e < 8; ++e) { const float a = AA[t * 64 + c8 + e]; kn[e] = k[e] * ckk[e >> 2][e & 3]; ss += kn[e] * kn[e];
            km[e] = k[e] * (1.f + (a - 1.f) * cka[e >> 2][e & 3]); bb[e] = a; bs += r[e] * km[e] * crk[e >> 2][e & 3]; }
        ss = sum8(ss); bs = sum8(bs);
        const float inv = rsqrtf(ss + 1e-6f);
        if ((tid & 7) == 0) gBS[t] = bs;
        float oKap[8], oBet[8], oKti[8], oRho[8], oBd[8], oKd[8];
#pragma unroll
        for (int e = 0; e < 8; ++e) { kn[e] *= inv; bb[e] *= kn[e];
            const float g = Af[t * 64 + c8 + e], gp = t > 0 ? Af[(t - 1) * 64 + c8 + e] : 0.f, gl = Af[63 * 64 + c8 + e];
            const float eg = __expf(g), ing = __expf(-g), egl = __expf(gl - g);
            oKap[e] = kn[e] * __expf(gp); oBet[e] = bb[e] * ing; oKti[e] = km[e] * ing; oRho[e] = r[e] * eg; oBd[e] = bb[e] * egl; oKd[e] = km[e] * egl; }
        const int lo = (t * 72 + c8) * 2;
#define ST8(dstp, a) do { u32x4 _w; _w.x = cvt_pk_bf16((a)[0], (a)[1]); _w.y = cvt_pk_bf16((a)[2], (a)[3]); _w.z = cvt_pk_bf16((a)[4], (a)[5]); _w.w = cvt_pk_bf16((a)[6], (a)[7]); *(u32x4*)(dstp) = _w; } while (0)
        ST8(sKap + lo, oKap); ST8(sBet + lo, oBet); ST8(sKti + lo, oKti); ST8(sRho + lo, oRho);
#define STT(base, a) do { _Pragma("unroll") for (int e_ = 0; e_ < 8; e_ += 2) { const unsigned w_ = cvt_pk_bf16((a)[e_], (a)[e_ + 1]); \
            *(bf16_t*)((base) + ((c8 + e_) * 72 + t) * 2) = (bf16_t)(w_ & 0xffffu); *(bf16_t*)((base) + ((c8 + e_ + 1) * 72 + t) * 2) = (bf16_t)(w_ >> 16); } } while (0)
        STT(X1, oKap); STT(sBd, oBd); STT(sKd, oKd); STT(sV, v);
#undef STT
#undef ST8
    }
    if (next_job >= 0) rw_load(p, next_job, in, tid);
    __syncthreads();
    {
        const int pidx = wave >> 1, tt0 = (wave & 1) * 2;
        const unsigned char* Xop = (pidx < 2) ? sKap : sRho; const unsigned char* Yop = (pidx & 1) ? sKti : sBet;
        unsigned char* dstb = pidx == 1 ? sBm : (pidx == 2 ? sAb : sAk);
#pragma unroll
        for (int q = 0; q < 2; ++q) { const int tt = tt0 + q, t = tt * 16 + l15;
            const bf16x8 x0 = ldfrag(Xop, 72, tt * 16, 0, lane), x1 = ldfrag(Xop, 72, tt * 16, 32, lane);
            bf16x8 yf[4][2]; f32x4 accs[4];
#pragma unroll
            for (int it = 0; it < 4; ++it) { yf[it][0] = ldfrag(Yop, 72, it * 16, 0, lane); yf[it][1] = ldfrag(Yop, 72, it * 16, 32, lane); }
#pragma unroll
            for (int it = 0; it < 4; ++it) accs[it] = MFMA16(yf[it][0], x0, ((f32x4){0.f, 0.f, 0.f, 0.f}));
#pragma unroll
            for (int it = 0; it < 4; ++it) accs[it] = MFMA16(yf[it][1], x1, accs[it]);
#pragma unroll
            for (int it = 0; it < 4; ++it) { f32x4 acc = accs[it];
                const int i0 = it * 16 + quad * 4;
#pragma unroll
                for (int j = 0; j < 4; ++j) { const bool keep = (pidx < 2) ? (i0 + j < t) : (i0 + j <= t); acc[j] = keep ? acc[j] : 0.f; }
                if (pidx == 0) *(f32x4*)(Af + t * 64 + i0) = acc; else *(u32x2*)(dstb + (t * 72 + i0) * 2) = PACK4(acc);
            } }
    }
    __syncthreads();
    inverse64(Af, Zf, sT, tid);
    {
        const int prod = wave >> 2, ct = wave & 3;
        const unsigned char* Asrc = prod ? sBm : sT; const unsigned char* Bsrc = prod ? sV : X1; unsigned char* dst = prod ? sX : sP1;
        const bf16x8 b0 = ldfrag(Bsrc, 72, ct * 16, 0, lane), b1 = ldfrag(Bsrc, 72, ct * 16, 32, lane);
        bf16x8 af[4][2]; f32x4 accs[4];
#pragma unroll
        for (int tt = 0; tt < 4; ++tt) { af[tt][0] = ldfrag(Asrc, 72, tt * 16, 0, lane); af[tt][1] = ldfrag(Asrc, 72, tt * 16, 32, lane); }
#pragma unroll
        for (int tt = 0; tt < 4; ++tt) accs[tt] = MFMA16(af[tt][0], b0, ((f32x4){0.f, 0.f, 0.f, 0.f}));
#pragma unroll
        for (int tt = 0; tt < 4; ++tt) accs[tt] = MFMA16(af[tt][1], b1, accs[tt]);
#pragma unroll
        for (int tt = 0; tt < 4; ++tt) *(u32x2*)(dst + ((ct * 16 + l15) * 72 + tt * 16 + quad * 4) * 2) = PACK4(accs[tt]);
    }
    __syncthreads();
    {
        const int vt = wave & 3, tt0 = (wave >> 2) * 2;
        const bf16x8 b0 = ldfrag(sX, 72, vt * 16, 0, lane), b1 = ldfrag(sX, 72, vt * 16, 32, lane);
        f32x4 acc[2]; bf16x8 tf[2][2];
#pragma unroll
        for (int q = 0; q < 2; ++q) { tf[q][0] = ldfrag(sT, 72, (tt0 + q) * 16, 0, lane); tf[q][1] = ldfrag(sT, 72, (tt0 + q) * 16, 32, lane); }
#pragma unroll
        for (int q = 0; q < 2; ++q) acc[q] = MFMA16(tf[q][0], b0, ((f32x4){0.f, 0.f, 0.f, 0.f}));
#pragma unroll
        for (int q = 0; q < 2; ++q) acc[q] = MFMA16(tf[q][1], b1, acc[q]);
#pragma unroll
        for (int q = 0; q < 2; ++q) *(u32x2*)(sP2 + ((vt * 16 + l15) * 72 + (tt0 + q) * 16 + quad * 4) * 2) = PACK4(acc[q]);
    }
    __syncthreads();
    {
        const int c = wave & 3, half = wave >> 2;
        const bf16x8 gp1a = ldfrag(sP1, 72, c * 16, 0, lane), gp1b = ldfrag(sP1, 72, c * 16, 32, lane);
        const bf16x8 gva = ldfrag(sV, 72, c * 16, 0, lane), gvb = ldfrag(sV, 72, c * 16, 32, lane);
        const bf16x8 gp2a = ldfrag(sP2, 72, c * 16, 0, lane), gp2b = ldfrag(sP2, 72, c * 16, 32, lane);
        bf16x8 gbd[2][2], gkd[2][2];
#pragma unroll
        for (int q = 0; q < 2; ++q) { const int kt = half * 2 + q;
            gbd[q][0] = ldfrag(sBd, 72, kt * 16, 0, lane); gbd[q][1] = ldfrag(sBd, 72, kt * 16, 32, lane);
            gkd[q][0] = ldfrag(sKd, 72, kt * 16, 0, lane); gkd[q][1] = ldfrag(sKd, 72, kt * 16, 32, lane); }
        const f32x4 zero4 = {0.f, 0.f, 0.f, 0.f};
#pragma unroll
        for (int q = 0; q < 2; ++q) { const int tt = half * 2 + q;
            const bf16x8 ab0 = ldfrag(sAb, 72, tt * 16, 0, lane), ab1 = ldfrag(sAb, 72, tt * 16, 32, lane), ak0 = ldfrag(sAk, 72, tt * 16, 0, lane), ak1 = ldfrag(sAk, 72, tt * 16, 32, lane);
            f32x4 aq = MFMA16(gp1a, ab0, zero4), a1 = MFMA16(ak0, gva, zero4), a2 = MFMA16(ab0, gp2a, zero4);
            aq = MFMA16(gp1b, ab1, aq); a1 = MFMA16(ak1, gvb, a1); a2 = MFMA16(ab1, gp2b, a2);
            const int t = tt * 16 + l15, k0 = c * 16 + quad * 4;
            const u32x2 rw = *(const u32x2*)(sRho + (t * 72 + k0) * 2);
            f32x4 ovq = {bf_lo(rw.x) - aq[0], bf_hi(rw.x) - aq[1], bf_lo(rw.y) - aq[2], bf_hi(rw.y) - aq[3]};
            *(u32x2*)(gQ + t * 64 + k0) = PACK4(ovq);
            f32x4 ovy = a1 - a2;
            *(u32x2*)(gY0 + ((tt * 4 + c) * 64 + lane) * 4) = PACK4(ovy); }
#pragma unroll
        for (int q = 0; q < 2; ++q) { const int kt = half * 2 + q;
            f32x4 af = MFMA16(gp1a, gbd[q][0], zero4), a1 = MFMA16(gkd[q][0], gva, zero4), a2 = MFMA16(gbd[q][0], gp2a, zero4);
            af = MFMA16(gp1b, gbd[q][1], af); a1 = MFMA16(gkd[q][1], gvb, a1); a2 = MFMA16(gbd[q][1], gp2b, a2);
            f32x4 ovf = {-af[0], -af[1], -af[2], -af[3]};
            *(u32x2*)(gF + (kt * 16 + l15) * 64 + c * 16 + quad * 4) = PACK4(ovf);
            f32x4 ovs = a1 - a2;
            *(u32x2*)(gS0 + ((kt * 4 + c) * 64 + lane) * 4) = PACK4(ovs); }
    }
    __syncthreads();
}

struct RwSet { u32x4 pq, pf; u32x2 py[4], ps[4]; float wc1; u32x4 cv, qv, gt; float bsc; };
__device__ __forceinline__ void rw_fetch(const Params& p, RwSet& s, int bh, int n, int b, int chn, int tid, int wave, int lane, int quad) {
    const bf16_t* P = (const bf16_t*)(p.ws + WS_P);
    const unsigned char* blk = rwp_ptr(p, bh * NCH + n);
    const int w4 = wave & 3;
    s.pq = *(const u32x4*)(blk + tid * 16); s.pf = *(const u32x4*)(blk + 8192 + tid * 16);
#pragma unroll
    for (int i = 0; i < 4; ++i) { s.py[i] = *(const u32x2*)(blk + 16384 + (((i * 4 + w4) * 64 + lane) * 8)); s.ps[i] = *(const u32x2*)(blk + 24576 + (((i * 4 + w4) * 64 + lane) * 8)); }
    s.wc1 = ((const float*)(blk + 32768))[tid & 63];
    const int tp = n * 64 + (tid >> 3) - 48, tpc = tp < 0 ? 0 : tp, tpp = tp < 1 ? 0 : tp - 1;
    const bf16_t* rowp = P + (size_t)rowof(b, tpc) * NP + chn;
    s.cv = *(const u32x4*)(rowp + C_V); s.gt = *(const u32x4*)(rowp + C_G); s.bsc = ((const float*)(blk + 33024))[tid >> 3];
    s.qv = *(const u32x4*)(P + (size_t)rowof(b, tpp) * NP + chn + C_V);
    if (tp < 1) s.qv = (u32x4){0u, 0u, 0u, 0u};
}
__device__ __forceinline__ void rw_chunk(const Params& p, RwSet& s, f32x4 (&S)[4], int bh, int n, int b, int chn, int tid, int wave, int lane, int l15, int quad,
                                         unsigned char* Ql, unsigned char* Fl, unsigned char* St, float* Yl, const float* Cst) {
    bf16_t* P = (bf16_t*)(p.ws + WS_P);
    const int pt = tid >> 3, pc8 = (tid & 7) * 8;
    __syncthreads();
    *(u32x4*)(Ql + ((tid >> 3) * 72 + (tid & 7) * 8) * 2) = s.pq; *(u32x4*)(Fl + ((tid >> 3) * 72 + (tid & 7) * 8) * 2) = s.pf;
    f32x4 y[4], sadd[4];
#pragma unroll
    for (int i = 0; i < 4; ++i) { y[i] = (f32x4){bf_lo(s.py[i].x), bf_hi(s.py[i].x), bf_lo(s.py[i].y), bf_hi(s.py[i].y)};
        sadd[i] = (f32x4){bf_lo(s.ps[i].x), bf_hi(s.ps[i].x), bf_lo(s.ps[i].y), bf_hi(s.ps[i].y)}; }
    float* WCl = Yl + 64 * 68 + 192;
    if (tid < 64) WCl[tid] = s.wc1;
    const u32x4 cv = s.cv, qv = s.qv, gt = s.gt; const float bsc = s.bsc;
    const int tp = n * 64 + pt - 48; const bool valid = tp >= 0;
    __syncthreads();
    if (n + 2 < NCH) rw_fetch(p, s, bh, n + 2, b, chn, tid, wave, lane, quad);
    if (wave < 4) {
#pragma unroll
        for (int kt = 0; kt < 4; ++kt) *(u32x2*)(St + (l15 * 72 + kt * 16 + quad * 4) * 2) = PACK4(S[kt]);
        asm volatile("s_waitcnt lgkmcnt(0)" ::: "memory");
        const bf16x8 sf0 = ldfrag(St, 72, 0, 0, lane), sf1 = ldfrag(St, 72, 0, 32, lane);
        bf16x8 fq[4][2], ff[4][2];
#pragma unroll
        for (int i = 0; i < 4; ++i) { ff[i][0] = ldfrag(Fl, 72, i * 16, 0, lane); ff[i][1] = ldfrag(Fl, 72, i * 16, 32, lane); }
#pragma unroll
        for (int i = 0; i < 4; ++i) { fq[i][0] = ldfrag(Ql, 72, i * 16, 0, lane); fq[i][1] = ldfrag(Ql, 72, i * 16, 32, lane); }
        f32x4 sn[4];
#pragma unroll
        for (int kt = 0; kt < 4; ++kt) sn[kt] = S[kt] * *(const f32x4*)(WCl + kt * 16 + quad * 4) + sadd[kt];
#pragma unroll
        for (int kt = 0; kt < 4; ++kt) sn[kt] = MFMA16(ff[kt][0], sf0, sn[kt]);
#pragma unroll
        for (int kt = 0; kt < 4; ++kt) S[kt] = MFMA16(ff[kt][1], sf1, sn[kt]);
#pragma unroll
        for (int ct = 0; ct < 4; ++ct) y[ct] = MFMA16(fq[ct][0], sf0, y[ct]);
#pragma unroll
        for (int ct = 0; ct < 4; ++ct) y[ct] = MFMA16(fq[ct][1], sf1, y[ct]);
#pragma unroll
        for (int ct = 0; ct < 4; ++ct)
#pragma unroll
            for (int j = 0; j < 4; ++j) Yl[(ct * 16 + quad * 4 + j) * 68 + wave * 16 + l15] = y[ct][j];
    }
    __syncthreads();
    {
        const f32x4 y0 = *(const f32x4*)(Yl + pt * 68 + pc8), y1 = *(const f32x4*)(Yl + pt * 68 + pc8 + 4);
        float yv[8] = {y0[0], y0[1], y0[2], y0[3], y1[0], y1[1], y1[2], y1[3]};
        float sm = 0.f;
#pragma unroll
        for (int e = 0; e < 8; ++e) sm += yv[e];
        sm = sum8(sm); const float mean = sm * (1.f / 64.f);
        float sq = 0.f;
#pragma unroll
        for (int e = 0; e < 8; ++e) { yv[e] -= mean; sq += yv[e] * yv[e]; }
        sq = sum8(sq); const float rstd = rsqrtf(sq * (1.f / 64.f) + 64e-5f);
        float ov[8], muv[8], gw[8], gb[8];
#pragma unroll
        for (int e = 0; e < 8; ++e) { muv[e] = Cst[pc8 + e]; gw[e] = Cst[64 + pc8 + e]; gb[e] = Cst[128 + pc8 + e]; }
#pragma unroll
        for (int e = 0; e < 4; ++e) {
            const float c0 = bf_lo(cv[e]), c1 = bf_hi(cv[e]);
            const float v0 = c0 + (bf_lo(qv[e]) - c0) * muv[2 * e], v1 = c1 + (bf_hi(qv[e]) - c1) * muv[2 * e + 1];
            ov[2 * e] = (yv[2 * e] * rstd * gw[2 * e] + gb[2 * e] + bsc * v0) * siluf_(bf_lo(gt[e]));
            ov[2 * e + 1] = (yv[2 * e + 1] * rstd * gw[2 * e + 1] + gb[2 * e + 1] + bsc * v1) * siluf_(bf_hi(gt[e])); }
        if (valid) { u32x4 w; w.x = cvt_pk_bf16(ov[0], ov[1]); w.y = cvt_pk_bf16(ov[2], ov[3]); w.z = cvt_pk_bf16(ov[4], ov[5]); w.w = cvt_pk_bf16(ov[6], ov[7]);
            *(u32x4*)(P + (size_t)rowof(b, tp) * NP + chn + C_G) = w; }
    }
}
__device__ __forceinline__ void rw_scan(const Params& p, int bh, unsigned char* lds) {
    const int b = bh >> 4, h = bh & 15, tid = opaque_tid(), lane = tid & 63, wave = tid >> 6, l15 = lane & 15, quad = lane >> 4;
    unsigned char* Ql = lds; unsigned char* Fl = lds + 9216;
    unsigned char* St = lds + 18432 + (wave & 3) * 2304;
    float* Yl = (float*)(lds + 27648);
    f32x4 S[4];
#pragma unroll
    for (int i = 0; i < 4; ++i) S[i] = (f32x4){0.f, 0.f, 0.f, 0.f};
    const int chn = h * 64 + (tid & 7) * 8;
    float* Cst = (float*)(lds + 45056);
    if (tid < 64) { Cst[tid] = p.mu[C_V + h * 64 + tid]; Cst[64 + tid] = p.gn_w[h * 64 + tid]; Cst[128 + tid] = p.gn_b[h * 64 + tid]; }
    RwSet s0, s1;
#pragma unroll
    for (int i = 0; i < 4; ++i) { s0.py[i] = (u32x2){0u, 0u}; s0.ps[i] = (u32x2){0u, 0u}; s1.py[i] = s0.py[i]; s1.ps[i] = s0.ps[i]; }
    rw_fetch(p, s0, bh, 0, b, chn, tid, wave, lane, quad);
    rw_fetch(p, s1, bh, 1, b, chn, tid, wave, lane, quad);
#pragma unroll 1
    for (int n = 0; n + 3 < NCH; n += 4) {
        rw_chunk(p, s0, S, bh, n, b, chn, tid, wave, lane, l15, quad, Ql, Fl, St, Yl, Cst);
        rw_chunk(p, s1, S, bh, n + 1, b, chn, tid, wave, lane, l15, quad, Ql, Fl, St, Yl, Cst);
        rw_chunk(p, s0, S, bh, n + 2, b, chn, tid, wave, lane, l15, quad, Ql, Fl, St, Yl, Cst);
        rw_chunk(p, s1, S, bh, n + 3, b, chn, tid, wave, lane, l15, quad, Ql, Fl, St, Yl, Cst);
    }
    static_assert(NCH % 4 == 1, "tail below handles exactly one chunk");
    rw_chunk(p, s0, S, bh, NCH - 1, b, chn, tid, wave, lane, l15, quad, Ql, Fl, St, Yl, Cst);
}
__global__ void __launch_bounds__(512, 2) hymba_fwd(Params p) {
    extern __shared__ __attribute__((aligned(16))) unsigned char lds[];
    cg::grid_group grid = cg::this_grid();
#define GSYNC() do { asm volatile("s_waitcnt vmcnt(0)" ::: "memory"); grid.sync(); \
        if (threadIdx.x < 64) { __builtin_amdgcn_fence(__ATOMIC_ACQUIRE, "agent"); asm volatile("s_waitcnt vmcnt(0)" ::: "memory"); } __syncthreads(); } while (0)
    const int G = gridDim.x, bid = blockIdx.x;
    volatile LAS unsigned* xbst = (volatile LAS unsigned*)((LAS unsigned char*)lds + (LDS_BYTES - 16));
    if (threadIdx.x == 0) { xbst[0] = 0u; xbst[1] = 0u; }
    __syncthreads();
    const XcdBarrier xbar = xcd_barrier_post((unsigned*)(p.ws + WS_BAR), xbst);
    bf16_t* P = (bf16_t*)(p.ws + WS_P);
    GSYNC();
    phase0(p, lds);
    xcd_barrier(xbar);
    {
        pg8::Gemm g{(const bf16_t*)(p.ws + WS_U), (const bf16_t*)(p.ws + WS_WINT), MP, NP, DM, DM};
        pg8::StaticOrder S; S.init(MP, NP, G, bid);
        pg8::EpiBf16 E{P, NP};
        pg8::gemm_phase<pg8::EpiBf16, pg8::StaticOrder, true, true>((PG8_LAS unsigned char*)lds, g, S, E);
    }
    xcd_barrier(xbar);
    {
        RwIn rin; int job = bid;
#pragma unroll
        for (int i = 0; i < 4; ++i) rin.mul[i] = *(const f32x4*)(p.mu + 3072 + (threadIdx.x & 7) * 16 + 4 * i);
        if (job < 64 * NCH) rw_load(p, job, rin, threadIdx.x);
        for (; job < 64 * NCH; job += G) rw_prep(p, job, lds, rin, job + G < 64 * NCH ? job + G : -1);
    }
    {
        DnIn din; int job = (bid + 192) % G;
        if (job < 32 * NCH) dn_load(p, job, din, threadIdx.x);
        for (; job < 32 * NCH; job += G) dn_prep(p, job, lds, din, job + G < 32 * NCH ? job + G : -1);
    }
    xcd_barrier(xbar);
    for (int job = bid; job < 64 + 32 * DN_PARTS; job += G) {
        if (job < 64) rw_scan(p, job, lds);
        else { const int q = job - 64, grp = q / (8 * DN_PARTS), r = q % (8 * DN_PARTS);
               dn_scan(p, grp * 8 + (r & 7), r >> 3, lds); }
        __syncthreads();
    }
    xcd_barrier(xbar);
    {
        const int tidp = opaque_tid(); DnPostIn pin, cur; int job = bid;
        if (job < 32 * NCH) dn_post_load(p, job, pin, tidp);
        for (; job < 32 * NCH; job += G) { cur = pin; if (job + G < 32 * NCH) dn_post_load(p, job + G, pin, tidp); dn_post(p, job, cur, tidp); }
    }
    xcd_barrier(xbar);
    if (G == 256) {
        pg8::Gemm g{P + C_G, (const bf16_t*)(p.ws + WS_WOUTT), NREAL, DM, DM, NP};
        pg8::PanelOrder S; S.c = bid;
        pg8::EpiResidNorm E{p.x, p.out, DM, (float*)(p.ws + WS_ROWSS), (unsigned*)(p.ws + WS_CNT), p.fnorm_w};
        pg8::gemm_phase<pg8::EpiResidNorm, pg8::PanelOrder, false, true>((PG8_LAS unsigned char*)lds, g, S, E);
    } else {
        {
            pg8::Gemm g{P + C_G, (const bf16_t*)(p.ws + WS_WOUTT), NREAL, DM, DM, NP};
            pg8::StaticOrder S; S.init(NREAL, DM, G, bid);
            pg8::EpiResid E{p.x, p.out, DM, (float*)(p.ws + WS_ROWSS)};
            pg8::gemm_phase<pg8::EpiResid, pg8::StaticOrder>((PG8_LAS unsigned char*)lds, g, S, E);
        }
        xcd_barrier(xbar);
        phase_final(p);
    }
}

extern "C" void kernel_launch(void* const* d_in, const int* in_sizes, int n_in, void* d_out, int out_size, void* d_ws, size_t ws_size, hipStream_t stream) {
    static int grid_blocks = 0;
    if (grid_blocks == 0) {
        if (n_in != 20 || ws_size < WS_END) { fprintf(stderr, "kernel_launch: unexpected n_in %d / ws_size %zu (need %zu)\n", n_in, ws_size, (size_t)WS_END); grid_blocks = -1; return; }
        int dev = 0, cus = 0, per_cu = 0;
        (void)hipGetDevice(&dev);
        (void)hipDeviceGetAttribute(&cus, hipDeviceAttributeMultiprocessorCount, dev);
        if (hipFuncSetAttribute((const void*)hymba_fwd, hipFuncAttributeMaxDynamicSharedMemorySize, LDS_BYTES) != hipSuccess) { fprintf(stderr, "kernel_launch: hipFuncSetAttribute failed\n"); grid_blocks = -1; return; }
        (void)hipOccupancyMaxActiveBlocksPerMultiprocessor(&per_cu, (const void*)hymba_fwd, 512, LDS_BYTES);
        (void)hipGetLastError();
        if (per_cu < 1) per_cu = 1;
        grid_blocks = cus * per_cu;
        if (grid_blocks > 256) grid_blocks = 256;
    }
    if (grid_blocks < 0) return;
    Params p{};
    p.x = (const float*)d_in[0]; p.meta = (const float*)d_in[1]; p.norm_w = (const float*)d_in[2]; p.w_in = (const float*)d_in[3]; p.mu = (const float*)d_in[4];
    p.w0 = (const float*)d_in[5]; p.w2 = (const float*)d_in[6]; p.a0 = (const float*)d_in[7]; p.a2 = (const float*)d_in[8]; p.k_k = (const float*)d_in[9];
    p.k_a = (const float*)d_in[10]; p.r_k = (const float*)d_in[11]; p.gn_w = (const float*)d_in[12]; p.gn_b = (const float*)d_in[13]; p.conv_w = (const float*)d_in[14];
    p.A_log = (const float*)d_in[15]; p.dt_bias = (const float*)d_in[16]; p.dn_norm_w = (const float*)d_in[17]; p.w_out = (const float*)d_in[18]; p.fnorm_w = (const float*)d_in[19];
    p.out = (float*)d_out; p.ws = (unsigned char*)d_ws;
    (void)hipMemsetAsync((unsigned char*)d_ws + WS_BAR, 0, 16384 + 128 * 256, stream);
    void* args[] = {&p};
    hipError_t e = hipLaunchCooperativeKernel((const void*)hymba_fwd, dim3(grid_blocks), dim3(512), args, LDS_BYTES, stream);
    if (e != hipSuccess) fprintf(stderr, "cooperative launch failed: %s (grid %d)\n", hipGetErrorString(e), grid_blocks);
}
```

```cpp
#include <hip/hip_runtime.h>
#include <hip/hip_cooperative_groups.h>
#include <cstdio>
#include <cstdint>
namespace cg = cooperative_groups;
#ifndef TESTMODE
#define TESTMODE 0
#endif

#define LAS __attribute__((address_space(3)))
typedef unsigned short bf16_t;
typedef short bf16x8 __attribute__((ext_vector_type(8)));
typedef float f32x4 __attribute__((ext_vector_type(4)));
typedef unsigned u32x2 __attribute__((ext_vector_type(2)));
typedef unsigned u32x4 __attribute__((ext_vector_type(4)));

constexpr int NB = 4, SEQ = 4096, NMETA = 16, LT = SEQ + NMETA, DM = 2048;
constexpr int NREAL = NB * SEQ;
constexpr int TOK = NB * LT;
constexpr int MP = 16640;
constexpr int NP = 8448;
constexpr int C_R = 0, C_K = 1024, C_V = 2048, C_G = 3072, C_Z = 4096, C_DQ = 5120, C_DK = 6144, C_DV = 7168;
constexpr int C_LW = 8192, C_LA = 8256, C_DB = 8320, C_DA = 8328;
constexpr int NCH = 65;
constexpr int LDS_BYTES = 147456;

constexpr size_t MiB = 1u << 20;
constexpr size_t WS_ROWSS = 500 * MiB;
constexpr size_t WS_BAR = 512 * 1024;
constexpr size_t WS_CNT = 512 * 1024 + 16384;
constexpr size_t WS_DNG = 256 * 1024;
constexpr size_t WS_WOUTT = 1 * MiB;
constexpr size_t WS_W2T = 9 * MiB;
constexpr size_t WS_A2T = 9 * MiB + 256 * 1024;
constexpr size_t WS_P = 10 * MiB;
constexpr size_t WS_U = 279 * MiB;
constexpr size_t WS_WINT = 344 * MiB;
constexpr size_t WS_DNP = 279 * MiB;
constexpr size_t WS_RWP = 426 * MiB;
constexpr size_t DNP_BLK = 73728;
constexpr size_t WS_END = 502 * MiB;

struct Params {
    const float* x; const float* meta; const float* norm_w; const float* w_in; const float* mu; const float* w0; const float* w2;
    const float* a0; const float* a2; const float* k_k; const float* k_a; const float* r_k; const float* gn_w; const float* gn_b;
    const float* conv_w; const float* A_log; const float* dt_bias; const float* dn_norm_w; const float* w_out; const float* fnorm_w;
    float* out; unsigned char* ws;
};

typedef float f32x2_t __attribute__((ext_vector_type(2)));
typedef __bf16 bf16x2_t __attribute__((ext_vector_type(2)));
__device__ __forceinline__ unsigned cvt_pk_bf16(float lo, float hi) { const f32x2_t v = {lo, hi}; return __builtin_bit_cast(unsigned, __builtin_convertvector(v, bf16x2_t)); }
__device__ __forceinline__ unsigned cvt_pk_bf16_asm(float lo, float hi) { unsigned r; asm volatile("v_cvt_pk_bf16_f32 %0, %1, %2" : "=v"(r) : "v"(lo), "v"(hi)); return r; }
__device__ __forceinline__ int opaque_tid() { int t = threadIdx.x; asm volatile("" : "+v"(t)); return t; }
__device__ __forceinline__ float bf_lo(unsigned w) { return __uint_as_float(w << 16); }
__device__ __forceinline__ float bf_hi(unsigned w) { return __uint_as_float(w & 0xffff0000u); }
__device__ __forceinline__ float bf2f(bf16_t b) { return __uint_as_float(((unsigned)b) << 16); }
__device__ __forceinline__ int rowof(int b, int tp) { return tp < NMETA ? NREAL + b * NMETA + tp : b * SEQ + tp - NMETA; }
__device__ __forceinline__ float sigmoidf_(float x) { return __builtin_amdgcn_rcpf(1.f + __expf(-x)); }
__device__ __forceinline__ float siluf_(float x) { return x * __builtin_amdgcn_rcpf(1.f + __expf(-x)); }
__device__ __forceinline__ float softplusf_(float x) { return fmaxf(x, 0.f) + log1pf(__expf(-fabsf(x))); }
__device__ __forceinline__ float dppf(float x, const int ctrl_sel) {
    int v = __float_as_int(x), r;
    if (ctrl_sel == 0) r = __builtin_amdgcn_update_dpp(0, v, 0xB1, 0xF, 0xF, false);
    else if (ctrl_sel == 1) r = __builtin_amdgcn_update_dpp(0, v, 0x4E, 0xF, 0xF, false);
    else if (ctrl_sel == 2) r = __builtin_amdgcn_update_dpp(0, v, 0x141, 0xF, 0xF, false);
    else r = __builtin_amdgcn_update_dpp(0, v, 0x140, 0xF, 0xF, false);
    return __int_as_float(r);
}
__device__ __forceinline__ float sum8(float x) { x += dppf(x, 0); x += dppf(x, 1); x += dppf(x, 2); return x; }
__device__ __forceinline__ float sum16(float x) { x = sum8(x); x += dppf(x, 3); return x; }
__device__ __forceinline__ bf16x8 ldfrag(const unsigned char* base, int ld_elems, int r0, int k0, int lane) {
    const int lo = ((lane & 15) * ld_elems + (lane >> 4) * 8) * 2;
    return *(const bf16x8*)(base + lo + (r0 * ld_elems + k0) * 2);
}
#define MFMA16(a, b, c) __builtin_amdgcn_mfma_f32_16x16x32_bf16((a), (b), (c), 0, 0, 0)

namespace pg8 {
#define PG8_LAS __attribute__((address_space(3)))
constexpr int BM = 256, BK = 64, HALF = 128, HTB = HALF * BK * 2, STAGE_BYTES = 8 * HTB, NXCD = 8, WGM = 8;
__host__ __device__ __forceinline__ int lds_byte(int r, int c) { const int st = (r >> 4) * 2 + (c >> 5), rr = r & 15, cc = c & 31, ob = rr * 64 + cc * 2; return st * 1024 + (ob ^ (((ob >> 9) & 1) << 5)); }
__host__ __device__ __forceinline__ void stage_rc(int b, int& R, int& C) { const int st = b / 1024, sb = b % 1024, swz = sb ^ (((sb >> 9) & 1) << 5); R = (st >> 1) * 16 + swz / 64; C = (st & 1) * 32 + (swz % 64) / 2; }
__host__ __device__ __forceinline__ int perm32(int rho) { const int n = rho >> 4, i = rho & 15; return 8 * (i >> 2) + 4 * n + (i & 3); }
struct Unit { int pm, pn; };
struct Gemm { const bf16_t* A; const bf16_t* Bt; int M, N, K, lda; };
struct StaticOrder {
    int nM, nN, nwg, G, c;
    __host__ __device__ void init(int M, int N, int G_, int c_) { nM = M / BM; nN = N / BM; nwg = nM * nN; G = G_; c = c_; }
    __host__ __device__ bool next(int i, Unit& u) const {
        const long L = (long)i * G + c; if (L >= nwg) return false;
        int wgid = (int)L; { const int q = nwg / NXCD, r = nwg % NXCD, xcd = wgid % NXCD, off = wgid / NXCD; wgid = (xcd < r ? xcd * (q + 1) : r * (q + 1) + (xcd - r) * q) + off; }
        const int nig = WGM * nN, gid = wgid / nig, fm = gid * WGM, gsz = (nM - fm) < WGM ? (nM - fm) : WGM;
        u.pm = fm + ((wgid % nig) % gsz); u.pn = (wgid % nig) / gsz; return true;
    }
    __device__ __forceinline__ void a_ready(const Unit&) const {}
    __device__ __forceinline__ void done(const Unit&) const {}
};
struct EpiBf16 {
    static constexpr bool PERM = true;
    bf16_t* O; int ldc;
    __device__ __forceinline__ void operator()(const f32x4 (&acc)[2][2][4][2], const Unit& u, int wr, int wc, int fr, int fq) const {
        const int row0 = u.pm * BM + wr * 64 + fr; const int col0 = u.pn * BM + wc * 32 + 8 * fq;
#pragma unroll
        for (int ai = 0; ai < 2; ++ai)
#pragma unroll
            for (int m = 0; m < 4; ++m) { bf16_t* rowp = O + (size_t)(row0 + ai * HALF + m * 16) * ldc + col0;
#pragma unroll
                for (int bj = 0; bj < 2; ++bj) { const f32x4 v0 = acc[ai][bj][m][0], v1 = acc[ai][bj][m][1];
                    u32x4 w; w.x = cvt_pk_bf16_asm(v0[0], v0[1]); w.y = cvt_pk_bf16_asm(v0[2], v0[3]); w.z = cvt_pk_bf16_asm(v1[0], v1[1]); w.w = cvt_pk_bf16_asm(v1[2], v1[3]);
                    *(u32x4*)(rowp + bj * HALF) = w; } }
    }
};
struct EpiResid {
    static constexpr bool PERM = false;
    const float* base; float* out; int ldc; float* rowss;
    __device__ __forceinline__ void operator()(const f32x4 (&acc)[2][2][4][2], const Unit& u, int wr, int wc, int fr, int fq) const {
        const int row0 = u.pm * BM + wr * 64 + fr, col0 = u.pn * BM + wc * 32 + 4 * fq;
#pragma unroll
        for (int ai = 0; ai < 2; ++ai)
#pragma unroll
            for (int m = 0; m < 4; ++m) { const int row = row0 + ai * HALF + m * 16; const size_t off = (size_t)row * ldc + col0; float ss = 0.f;
#pragma unroll
                for (int bj = 0; bj < 2; ++bj)
#pragma unroll
                    for (int n = 0; n < 2; ++n) { const f32x4 bs = *(const f32x4*)(base + off + bj * HALF + n * 16); const f32x4 v = bs + acc[ai][bj][m][n];
                        *(f32x4*)(out + off + bj * HALF + n * 16) = v; ss += v[0] * v[0] + v[1] * v[1] + v[2] * v[2] + v[3] * v[3]; }
                ss += __shfl_xor(ss, 16); ss += __shfl_xor(ss, 32);
                if (fq == 0) rowss[(size_t)row * 32 + u.pn * 4 + wc] = ss; }
    }
};

struct EpiResidNorm {
    static constexpr bool PERM = false;
    const float* base; float* out; int ldc; float* rowss; unsigned* cnt; const float* fw;
    __device__ __forceinline__ void operator()(f32x4 (&acc)[2][2][4][2], const Unit& u, int wr, int wc, int fr, int fq) const {
        const int row0 = u.pm * BM + wr * 64 + fr, col0 = u.pn * BM + wc * 32 + 4 * fq;
#pragma unroll
        for (int ai = 0; ai < 2; ++ai)
#pragma unroll
            for (int m = 0; m < 4; ++m) { const int row = row0 + ai * HALF + m * 16; const size_t off = (size_t)row * ldc + col0; float ss = 0.f;
#pragma unroll
                for (int bj = 0; bj < 2; ++bj)
#pragma unroll
                    for (int n = 0; n < 2; ++n) { const f32x4 bs = *(const f32x4*)(base + off + bj * HALF + n * 16); const f32x4 v = bs + acc[ai][bj][m][n];
                        acc[ai][bj][m][n] = v; ss += v[0] * v[0] + v[1] * v[1] + v[2] * v[2] + v[3] * v[3]; }
                ss += __shfl_xor(ss, 16); ss += __shfl_xor(ss, 32);
                if (fq == 0) __hip_atomic_store(rowss + (size_t)row * 32 + u.pn * 4 + wc, ss, __ATOMIC_RELAXED, __HIP_MEMORY_SCOPE_AGENT); }
        asm volatile("s_waitcnt vmcnt(0)" ::: "memory");
        unsigned* c = cnt + (u.pm * 2 + wr) * 64;
        if ((threadIdx.x & 63) == 0) (void)__hip_atomic_fetch_add(c, 1u, __ATOMIC_RELAXED, __HIP_MEMORY_SCOPE_AGENT);
        {   unsigned spins = 0;
            while ((unsigned)__builtin_amdgcn_readfirstlane((int)__hip_atomic_load(c, __ATOMIC_RELAXED, __HIP_MEMORY_SCOPE_AGENT)) < 32u) { __builtin_amdgcn_s_sleep(2); if (++spins > (1u << 22)) break; } }
        __builtin_amdgcn_fence(__ATOMIC_ACQUIRE, "agent");
        asm volatile("s_waitcnt vmcnt(0)" ::: "memory");
        f32x4 fwv[2][2];
#pragma unroll
        for (int bj = 0; bj < 2; ++bj)
#pragma unroll
            for (int n = 0; n < 2; ++n) fwv[bj][n] = *(const f32x4*)(fw + col0 + bj * HALF + n * 16);
#pragma unroll
        for (int ai = 0; ai < 2; ++ai)
#pragma unroll
            for (int m = 0; m < 4; ++m) { const int row = row0 + ai * HALF + m * 16; const size_t off = (size_t)row * ldc + col0;
                const f32x4 p0 = *(const f32x4*)(rowss + (size_t)row * 32 + fq * 8), p1 = *(const f32x4*)(rowss + (size_t)row * 32 + fq * 8 + 4);
                float t = ((p0[0] + p0[1]) + (p0[2] + p0[3])) + ((p1[0] + p1[1]) + (p1[2] + p1[3]));
                t += __shfl_xor(t, 16); t += __shfl_xor(t, 32);
                const float sc = rsqrtf(t * (1.f / 2048.f) + 1e-6f);
#pragma unroll
                for (int bj = 0; bj < 2; ++bj)
#pragma unroll
                    for (int n = 0; n < 2; ++n) { const f32x4 v = acc[ai][bj][m][n], w = fwv[bj][n];
                        *(f32x4*)(out + off + bj * HALF + n * 16) = (f32x4){v[0] * sc * w[0], v[1] * sc * w[1], v[2] * sc * w[2], v[3] * sc * w[3]}; } }
    }
};
struct PanelOrder {
    int c;
    __device__ bool next(int i, Unit& u) const { if (i >= 2) return false; const int x = c & 7, y = c >> 3; u.pm = 32 * i + 4 * x + (y >> 3); u.pn = y & 7; return true; }
    __device__ __forceinline__ void a_ready(const Unit&) const {}
    __device__ __forceinline__ void done(const Unit&) const {}
};

template <class Epi, class Sched, bool ALIGN_EPI = false, bool SP2 = false>
__device__ __forceinline__ void gemm_phase(PG8_LAS unsigned char* lds, const Gemm g, const Sched& S, const Epi& E) {
    const int tid = opaque_tid(), wid = __builtin_amdgcn_readfirstlane(tid >> 6), lane = tid & 63, wr = wid >> 2, wc = wid & 3, fr = lane & 15, fq = lane >> 4;
    const int K = g.K, nt = K / BK, lda = g.lda;
    unsigned voffA[2], voffB[2];
#pragma unroll
    for (int i = 0; i < 2; ++i) { int R, C; stage_rc(tid * 16 + i * 8192, R, C); const int Rb = Epi::PERM ? ((R & ~31) + perm32(R & 31)) : R;
        voffA[i] = (unsigned)(R * lda + C) * 2u; voffB[i] = (unsigned)(Rb * K + C) * 2u; }
    const size_t kstep = (size_t)(BK * 2);
    const size_t hstepA = (size_t)HALF * lda * 2, hstepB = (size_t)HALF * K * 2;
    const size_t tstepA = 2 * hstepA, tstepB = 2 * hstepB;
    const unsigned ldsw = (unsigned)wid * 1024u;
    const int aoff = lds_byte(wr * 64 + fr, fq * 8), boff = lds_byte(wc * 32 + fr, fq * 8);
#define PG8_SA(b, h) (((b) * 2 + (h)) * HTB)
#define PG8_SB(b, h) ((4 + (b) * 2 + (h)) * HTB)
#define PG8_STAGE(bufoff, gbase, voff) do { _Pragma("unroll") for (int _i = 0; _i < 2; ++_i) \
        __builtin_amdgcn_global_load_lds((const unsigned*)((const char*)(gbase) + (voff)[_i]), (PG8_LAS unsigned*)(lds + (bufoff) + ldsw + _i * 8192), 16, 0, 0); } while (0)
#define PG8_LDA(dst, b, h) do { _Pragma("unroll") for (int m = 0; m < 4; ++m) _Pragma("unroll") for (int k = 0; k < 2; ++k) dst[m][k] = *(const PG8_LAS bf16x8*)(lds + PG8_SA(b, h) + aoff + m * 2048 + k * 1024); } while (0)
#define PG8_LDB(dst, b, h) do { _Pragma("unroll") for (int n = 0; n < 2; ++n) _Pragma("unroll") for (int k = 0; k < 2; ++k) dst[n][k] = *(const PG8_LAS bf16x8*)(lds + PG8_SB(b, h) + boff + n * 2048 + k * 1024); } while (0)
#define PG8_MMA(ai, bj, At, Bt) do { __builtin_amdgcn_s_setprio(1); _Pragma("unroll") for (int m = 0; m < 4; ++m) _Pragma("unroll") for (int n = 0; n < 2; ++n) _Pragma("unroll") for (int k = 0; k < 2; ++k) \
        acc[ai][bj][m][n] = __builtin_amdgcn_mfma_f32_16x16x32_bf16(Bt[n][k], At[m][k], acc[ai][bj][m][n], 0, 0, 0); __builtin_amdgcn_s_setprio(0); } while (0)
#define PG8_WAIT_V(n) asm volatile("s_waitcnt vmcnt(" #n ")" ::: "memory")
#define PG8_WAIT_L(n) asm volatile("s_waitcnt lgkmcnt(" #n ")" ::: "memory")
#define PG8_BAR __builtin_amdgcn_s_barrier()
#define PG8_SCHED __builtin_amdgcn_sched_barrier(0)
    Unit cur, nxt; int ui = 0;
    if (!S.next(0, cur)) return;
    f32x4 acc[2][2][4][2];
#pragma unroll
    for (int a = 0; a < 2; ++a)
#pragma unroll
        for (int b = 0; b < 2; ++b)
#pragma unroll
            for (int m = 0; m < 4; ++m)
#pragma unroll
                for (int n = 0; n < 2; ++n) acc[a][b][m][n] = (f32x4){0.f, 0.f, 0.f, 0.f};
    bf16x8 At[4][2], B0[2][2], B1[2][2];
    const char* cA = (const char*)g.A + (size_t)cur.pm * tstepA; const char* cB = (const char*)g.Bt + (size_t)cur.pn * tstepB;
    S.a_ready(cur);
    if constexpr (SP2) {
        PG8_STAGE(PG8_SB(0, 0), cB, voffB); PG8_STAGE(PG8_SB(0, 1), cB + hstepB, voffB); PG8_STAGE(PG8_SA(0, 0), cA, voffA); PG8_STAGE(PG8_SA(0, 1), cA + hstepA, voffA);
        if (wr == 1) PG8_BAR;
        PG8_WAIT_V(2); PG8_BAR;
        PG8_STAGE(PG8_SB(1, 0), cB + kstep, voffB); PG8_STAGE(PG8_SA(1, 0), cA + kstep, voffA); PG8_STAGE(PG8_SB(1, 1), cB + hstepB + kstep, voffB);
        PG8_WAIT_V(6); PG8_BAR;
    } else {
    PG8_STAGE(PG8_SB(0, 0), cB, voffB); PG8_STAGE(PG8_SA(0, 0), cA, voffA); PG8_STAGE(PG8_SB(0, 1), cB + hstepB, voffB); PG8_STAGE(PG8_SA(0, 1), cA + hstepA, voffA);
    if (wr == 1) PG8_BAR;
    PG8_WAIT_V(4); PG8_BAR;
    PG8_STAGE(PG8_SB(1, 0), cB + kstep, voffB); PG8_STAGE(PG8_SA(1, 0), cA + kstep, voffA); PG8_STAGE(PG8_SB(1, 1), cB + hstepB + kstep, voffB);
    PG8_WAIT_V(6); PG8_BAR;
    }
    for (;;) {
        const bool has_next = S.next(ui + 1, nxt);
        const char* nA = has_next ? (const char*)g.A + (size_t)nxt.pm * tstepA : cA; const char* nB = has_next ? (const char*)g.Bt + (size_t)nxt.pn * tstepB : cB;
        for (int t = 0; t < nt; t += 2) {
            const bool last = (t == nt - 2);
            const char* a1 = cA + (size_t)(t + 1) * kstep;
            const char* a2 = last ? nA : cA + (size_t)(t + 2) * kstep; const char* b2 = last ? nB : cB + (size_t)(t + 2) * kstep;
            const char* a3 = a2 + kstep; const char* b3 = b2 + kstep;
            if (last && has_next) S.a_ready(nxt);
            if constexpr (SP2) {
            PG8_LDB(B0, 0, 0); PG8_LDB(B1, 0, 1); PG8_SCHED; PG8_LDA(At, 0, 0); PG8_STAGE(PG8_SA(1, 1), a1 + hstepA, voffA);
            PG8_WAIT_V(8); PG8_WAIT_L(0); PG8_BAR; PG8_MMA(0, 0, At, B0); PG8_MMA(0, 1, At, B1); PG8_BAR; PG8_SCHED;
            PG8_LDA(At, 0, 1); PG8_STAGE(PG8_SB(0, 0), b2, voffB); PG8_STAGE(PG8_SB(0, 1), b2 + hstepB, voffB); PG8_STAGE(PG8_SA(0, 0), a2, voffA);
            PG8_WAIT_V(8); PG8_WAIT_L(0); PG8_BAR; PG8_MMA(1, 0, At, B0); PG8_MMA(1, 1, At, B1); PG8_BAR; PG8_SCHED;
            PG8_LDB(B0, 1, 0); PG8_LDB(B1, 1, 1); PG8_SCHED; PG8_LDA(At, 1, 0); PG8_STAGE(PG8_SA(0, 1), a2 + hstepA, voffA);
            PG8_WAIT_V(8); PG8_WAIT_L(0); PG8_BAR; PG8_MMA(0, 0, At, B0); PG8_MMA(0, 1, At, B1); PG8_BAR; PG8_SCHED;
            PG8_LDA(At, 1, 1); PG8_STAGE(PG8_SB(1, 0), b3, voffB); PG8_STAGE(PG8_SB(1, 1), b3 + hstepB, voffB); PG8_STAGE(PG8_SA(1, 0), a3, voffA);
            PG8_WAIT_V(8); PG8_WAIT_L(0); PG8_BAR; PG8_MMA(1, 0, At, B0); PG8_MMA(1, 1, At, B1); PG8_BAR; PG8_SCHED;
            } else {
            PG8_LDB(B0, 0, 0); PG8_SCHED; PG8_LDA(At, 0, 0); PG8_STAGE(PG8_SA(1, 1), a1 + hstepA, voffA);
            PG8_WAIT_L(8); PG8_BAR; PG8_WAIT_L(0); PG8_MMA(0, 0, At, B0); PG8_BAR; PG8_SCHED;
            PG8_LDB(B1, 0, 1); PG8_STAGE(PG8_SB(0, 0), b2, voffB);
            PG8_BAR; PG8_WAIT_L(0); PG8_MMA(0, 1, At, B1); PG8_BAR;
            PG8_LDA(At, 0, 1); PG8_STAGE(PG8_SA(0, 0), a2, voffA);
            PG8_BAR; PG8_WAIT_L(0); PG8_MMA(1, 0, At, B0); PG8_BAR; PG8_SCHED;
            PG8_STAGE(PG8_SB(0, 1), b2 + hstepB, voffB);
            PG8_WAIT_V(6); PG8_BAR; PG8_MMA(1, 1, At, B1); PG8_BAR;
            PG8_LDB(B0, 1, 0); PG8_SCHED; PG8_LDA(At, 1, 0); PG8_STAGE(PG8_SA(0, 1), a2 + hstepA, voffA);
            PG8_WAIT_L(8); PG8_BAR; PG8_WAIT_L(0); PG8_MMA(0, 0, At, B0); PG8_BAR; PG8_SCHED;
            PG8_LDB(B1, 1, 1); PG8_STAGE(PG8_SB(1, 0), b3, voffB);
            PG8_BAR; PG8_WAIT_L(0); PG8_MMA(0, 1, At, B1); PG8_BAR;
            PG8_LDA(At, 1, 1); PG8_STAGE(PG8_SA(1, 0), a3, voffA);
            PG8_BAR; PG8_WAIT_L(0); PG8_MMA(1, 0, At, B0); PG8_BAR; PG8_SCHED;
            PG8_STAGE(PG8_SB(1, 1), b3 + hstepB, voffB);
            PG8_WAIT_V(6); PG8_BAR; PG8_MMA(1, 1, At, B1); PG8_BAR;
            }
        }
        if constexpr (ALIGN_EPI) { if (wr == 0) PG8_BAR; }
        E(acc, cur, wr, wc, fr, fq); S.done(cur);
        if (!has_next) break;
#pragma unroll
        for (int a = 0; a < 2; ++a)
#pragma unroll
            for (int b = 0; b < 2; ++b)
#pragma unroll
                for (int m = 0; m < 4; ++m)
#pragma unroll
                    for (int n = 0; n < 2; ++n) acc[a][b][m][n] = (f32x4){0.f, 0.f, 0.f, 0.f};
        cur = nxt; cA = nA; cB = nB; ++ui;
        if constexpr (ALIGN_EPI) { if (wr == 1) PG8_BAR; }
    }
    PG8_WAIT_V(0);
    if constexpr (!ALIGN_EPI) { if (wr == 0) PG8_BAR; }
    PG8_BAR;
#undef PG8_SA
#undef PG8_SB
#undef PG8_STAGE
#undef PG8_LDA
#undef PG8_LDB
#undef PG8_MMA
#undef PG8_WAIT_V
#undef PG8_WAIT_L
#undef PG8_BAR
#undef PG8_SCHED
}
}

__device__ __forceinline__ int refcol_win(int j) {
    if (j < 3072) return j;
    if (j < 4096) return 3200 + (j - 3072);
    if (j < 5120) return 7312 + (j - 4096);
    if (j < 8192) return 4224 + (j - 5120);
    if (j < 8320) return 3072 + (j - 8192);
    if (j < 8336) return 7296 + (j - 8320);
    return -1;
}
struct TJob { const float* src; bf16_t* dst; int src_ld, dst_ld, j0, k0, K; bool winmap; };
__device__ __forceinline__ TJob p0_decode(const Params& p, int job) {
    constexpr int J_WIN = (NP / 64) * 16, J_WOUT = (DM / 64) * 16, J_L = 16;
    TJob t;
    if (job < J_WIN) { t.src = p.w_in; t.src_ld = 8336; t.dst = (bf16_t*)(p.ws + WS_WINT); t.dst_ld = DM; t.j0 = (job >> 4) * 64; t.k0 = (job & 15) * 128; t.K = DM; t.winmap = true; }
    else if (job < J_WIN + J_WOUT) { const int q = job - J_WIN; t.src = p.w_out; t.src_ld = DM; t.dst = (bf16_t*)(p.ws + WS_WOUTT); t.dst_ld = DM; t.j0 = (q >> 4) * 64; t.k0 = (q & 15) * 128; t.K = DM; t.winmap = false; }
    else if (job < J_WIN + J_WOUT + J_L) { const int q = job - J_WIN - J_WOUT; t.src = p.w2; t.src_ld = 1024; t.dst = (bf16_t*)(p.ws + WS_W2T); t.dst_ld = 64; t.j0 = q * 64; t.k0 = 0; t.K = 64; t.winmap = false; }
    else { const int q = job - J_WIN - J_WOUT - J_L; t.src = p.a2; t.src_ld = 1024; t.dst = (bf16_t*)(p.ws + WS_A2T); t.dst_ld = 64; t.j0 = q * 64; t.k0 = 0; t.K = 64; t.winmap = false; }
    return t;
}
__device__ __forceinline__ void p0_load(const TJob& t, int tid, float (&v)[16]) {
    const int jj = tid & 63, j = t.j0 + jj; const int rc = t.winmap ? refcol_win(j) : j;
#pragma unroll
    for (int i = 0; i < 16; ++i) { const int k = t.k0 + i * 8 + (tid >> 6); v[i] = (rc >= 0 && k < t.K) ? t.src[(size_t)k * t.src_ld + rc] : 0.f; }
}
__device__ __forceinline__ void phase0(const Params& p, unsigned char* lds) {
    float* tile = (float*)lds;
    const int tid = opaque_tid(), G = gridDim.x, bid = blockIdx.x;
    constexpr int NJ = (NP / 64) * 16 + (DM / 64) * 16 + 32;
    {
        float v[16]; int job = bid;
        TJob t = p0_decode(p, job < NJ ? job : 0);
        if (job < NJ) p0_load(t, tid, v);
        while (job < NJ) {
            { const int jj = tid & 63;
#pragma unroll
              for (int i = 0; i < 16; ++i) tile[(i * 8 + (tid >> 6)) * 65 + jj] = v[i]; }
            __syncthreads();
            const int nxt = job + G; const TJob tn = p0_decode(p, nxt < NJ ? nxt : 0);
            if (nxt < NJ) p0_load(tn, tid, v);
            { const int jj = tid >> 3, kg = tid & 7;
#pragma unroll
              for (int half = 0; half < 2; ++half) { const int kb = half * 64 + kg * 8;
                  if (t.k0 + kb < t.K) { float x[8];
#pragma unroll
                      for (int i = 0; i < 8; ++i) x[i] = tile[(kb + i) * 65 + jj];
                      u32x4 w; w.x = cvt_pk_bf16(x[0], x[1]); w.y = cvt_pk_bf16(x[2], x[3]); w.z = cvt_pk_bf16(x[4], x[5]); w.w = cvt_pk_bf16(x[6], x[7]);
                      *(u32x4*)(t.dst + (size_t)(t.j0 + jj) * t.dst_ld + t.k0 + kb) = w; } } }
            __syncthreads();
            t = tn; job = nxt;
        }
    }
    bf16_t* U = (bf16_t*)(p.ws + WS_U);
    const int lane = tid & 63, gw = bid * 8 + (tid >> 6), nw = G * 8;
#define P0_ROWSRC(mm) ((const f32x4*)((mm) < NREAL ? p.x + (size_t)(mm) * DM : p.meta + (size_t)(((mm) - NREAL) & 15) * DM))
    f32x4 v[8];
#pragma unroll
    for (int i = 0; i < 8; ++i) v[i] = (f32x4){0.f, 0.f, 0.f, 0.f};
    if (gw < TOK) { const f32x4* src = P0_ROWSRC(gw);
#pragma unroll
        for (int i = 0; i < 8; ++i) v[i] = src[i * 64 + lane]; }
    for (int m = gw; m < MP; m += nw) {
        const int mn = m + nw; f32x4 vn[8];
#pragma unroll
        for (int i = 0; i < 8; ++i) vn[i] = (f32x4){0.f, 0.f, 0.f, 0.f};
        if (mn < TOK) { const f32x4* srcn = P0_ROWSRC(mn);
#pragma unroll
            for (int i = 0; i < 8; ++i) vn[i] = srcn[i * 64 + lane]; }
        u32x2* dst = (u32x2*)(U + (size_t)m * DM);
        if (m >= TOK) {
#pragma unroll
            for (int i = 0; i < 8; ++i) dst[i * 64 + lane] = (u32x2){0u, 0u};
        } else {
            float ss = 0.f;
#pragma unroll
            for (int i = 0; i < 8; ++i) ss += v[i][0] * v[i][0] + v[i][1] * v[i][1] + v[i][2] * v[i][2] + v[i][3] * v[i][3];
#pragma unroll
            for (int o = 32; o >= 1; o >>= 1) ss += __shfl_xor(ss, o);
            const float sc = rsqrtf(ss * (1.f / DM) + 1e-6f);
#pragma unroll
            for (int i = 0; i < 8; ++i) { const f32x4 nw4 = ((const f32x4*)p.norm_w)[i * 64 + lane];
                dst[i * 64 + lane] = (u32x2){cvt_pk_bf16(v[i][0] * sc * nw4[0], v[i][1] * sc * nw4[1]), cvt_pk_bf16(v[i][2] * sc * nw4[2], v[i][3] * sc * nw4[3])}; }
        }
#pragma unroll
        for (int i = 0; i < 8; ++i) v[i] = vn[i];
    }
#undef P0_ROWSRC
}

__device__ __forceinline__ void phase_final(const Params& p) {
    const float* rowss = (const float*)(p.ws + WS_ROWSS);
    const int tid = opaque_tid(), lane = tid & 63;
    const f32x4* fw4 = (const f32x4*)p.fnorm_w;
    f32x4 w[8];
#pragma unroll
    for (int i = 0; i < 8; ++i) w[i] = fw4[i * 64 + lane];
    for (int row = blockIdx.x * 8 + (tid >> 6); row < NREAL; row += gridDim.x * 8) {
        float ss = lane < 32 ? rowss[(size_t)row * 32 + lane] : 0.f;
#pragma unroll
        for (int o = 16; o >= 1; o >>= 1) ss += __shfl_xor(ss, o);
        ss = __shfl(ss, 0);
        const float sc = rsqrtf(ss * (1.f / DM) + 1e-6f);
        f32x4* o4 = (f32x4*)(p.out + (size_t)row * DM);
        f32x4 v[8];
#pragma unroll
        for (int i = 0; i < 8; ++i) v[i] = o4[i * 64 + lane];
#pragma unroll
        for (int i = 0; i < 8; ++i) { v[i][0] *= sc * w[i][0]; v[i][1] *= sc * w[i][1]; v[i][2] *= sc * w[i][2]; v[i][3] *= sc * w[i][3]; o4[i * 64 + lane] = v[i]; }
    }
}

#define XB_TMO      128
#define XB_XCNT(j)  (256  + 64 * (j))
#define XB_XSUB(j)  (1280 + 64 * (j))
#define XB_XGEN(j)  (2304 + 64 * (j))
#define XB_TOP      3328
#define XB_TOPGEN   3392
#define XCD_BAR_WORDS 3456
#define XB_SPIN_CAP (1u << 18)

__device__ __forceinline__ unsigned xb_ld(unsigned* p)              { return __hip_atomic_load(p, __ATOMIC_RELAXED, __HIP_MEMORY_SCOPE_AGENT); }
__device__ __forceinline__ unsigned xb_add(unsigned* p, unsigned v) { return __hip_atomic_fetch_add(p, v, __ATOMIC_RELAXED, __HIP_MEMORY_SCOPE_AGENT); }
__device__ __forceinline__ unsigned xb_xcc_id() { return (unsigned)__builtin_amdgcn_s_getreg((3 << 11) | 20) & 0xFu; }
#define XB_SPIN(cond, bar) do { unsigned _sp = 0; while (cond) { __builtin_amdgcn_s_sleep(1); \
    if ((++_sp & 255u) == 0u) { if (xb_ld(&(bar)[XB_TMO])) break; if (_sp > XB_SPIN_CAP) { atomicAdd(&(bar)[XB_TMO], 1u); break; } } } } while (0)

struct XcdBarrier {
    unsigned* bar; unsigned x;
    volatile LAS unsigned* st;
};

__device__ __forceinline__ XcdBarrier xcd_barrier_post(unsigned* bar, volatile LAS unsigned* st) {
    XcdBarrier b; b.bar = bar; b.x = xb_xcc_id(); b.st = st;
    if (threadIdx.x == 0) (void)xb_add(&bar[XB_XCNT(b.x)], 1u);
    return b;
}
__device__ __forceinline__ void xcd_barrier_complete(unsigned* bar, unsigned x, unsigned& nloc, unsigned& nx) {
    const unsigned G = gridDim.x * gridDim.y * gridDim.z;
    unsigned sum, cnt, mine, sp = 0u;
    for (;;) {
        sum = 0u; cnt = 0u; mine = 0u;
#pragma unroll
        for (unsigned j = 0; j < 16; ++j) { const unsigned c = xb_ld(&bar[XB_XCNT(j)]); sum += c; cnt += (c > 0u) ? 1u : 0u; mine = (j == x) ? c : mine; }
        if (sum == G) break;
        __builtin_amdgcn_s_sleep(1);
        if ((++sp & 255u) == 0u) { if (xb_ld(&bar[XB_TMO])) break; if (sp > XB_SPIN_CAP) { atomicAdd(&bar[XB_TMO], 1u); break; } }
    }
    nloc = mine > 0u ? mine : 1u; nx = cnt > 0u ? cnt : 1u;
}

__device__ __forceinline__ void xcd_barrier(const XcdBarrier& b) {
    asm volatile("s_waitcnt vmcnt(0)" ::: "memory");
    __syncthreads();
    if (threadIdx.x == 0) {
        unsigned* bar = b.bar;
        __builtin_amdgcn_s_waitcnt(0);
        unsigned nloc = b.st[0], nx = b.st[1];
        if (nloc == 0u) { xcd_barrier_complete(bar, b.x, nloc, nx); b.st[0] = nloc; b.st[1] = nx; }
        const unsigned old = xb_add(&bar[XB_XSUB(b.x)], 1u);
        const unsigned gen = old / nloc;
        if (old + 1u == (gen + 1u) * nloc) {
            __builtin_amdgcn_fence(__ATOMIC_RELEASE, "agent");
            asm volatile("s_waitcnt vmcnt(0)" ::: "memory");
            const unsigned og = xb_add(&bar[XB_TOP], 1u);
            const unsigned tg = og / nx;
            if (og + 1u == (tg + 1u) * nx) xb_add(&bar[XB_TOPGEN], 1u);
            else XB_SPIN(xb_ld(&bar[XB_TOPGEN]) == tg, bar);
            __builtin_amdgcn_fence(__ATOMIC_ACQUIRE, "agent");
            xb_add(&bar[XB_XGEN(b.x)], 1u);
            asm volatile("s_waitcnt vmcnt(0)" ::: "memory");
        } else {
            XB_SPIN(xb_ld(&bar[XB_XGEN(b.x)]) == gen, bar);
            __builtin_amdgcn_fence(__ATOMIC_ACQUIRE, "agent");
            asm volatile("s_waitcnt vmcnt(0)" ::: "memory");
        }
    }
    __syncthreads();
}


__device__ __forceinline__ void inverse64(float* Af, float* Zf, unsigned char* Tb, int tid) {
    const int lane = tid & 63, wave = tid >> 6;
    const int l15 = lane & 15, quad = lane >> 4;
    if (wave < 4) {
        const int o = wave * 16, col = l15;
        float t[16]; int roff = 0;
#pragma unroll
        for (int i = 0; i < 16; ++i) {
            if ((i & 1) == 0 && i >= 2) asm volatile("" : "+v"(roff) : "v"(t[i - 2]));
            float a0 = (i == col) ? 1.f : 0.f, a1 = 0.f, a2 = 0.f, a3 = 0.f;
#pragma unroll
            for (int j4 = 0; j4 < (i + 3) / 4; ++j4) { const f32x4 mv = *(const f32x4*)(Af + roff + (o + i) * 64 + o + j4 * 4);
                if (j4 * 4 + 0 < i) a0 -= mv[0] * t[j4 * 4 + 0];
                if (j4 * 4 + 1 < i) a1 -= mv[1] * t[j4 * 4 + 1];
                if (j4 * 4 + 2 < i) a2 -= mv[2] * t[j4 * 4 + 2];
                if (j4 * 4 + 3 < i) a3 -= mv[3] * t[j4 * 4 + 3]; }
            t[i] = (a0 + a1) + (a2 + a3);
        }
        asm volatile("s_waitcnt lgkmcnt(0)" ::: "memory");
        if (lane < 16) {
#pragma unroll
            for (int i = 0; i < 16; ++i) Af[(o + i) * 64 + o + col] = t[i]; }
    }
    __syncthreads();
    if (wave < 2) {
        const int o = wave * 32; f32x4 acc = {0.f, 0.f, 0.f, 0.f}, accb = {0.f, 0.f, 0.f, 0.f};
#pragma unroll
        for (int ks = 0; ks < 4; ++ks) { if (ks & 1) accb = __builtin_amdgcn_mfma_f32_16x16x4f32(Af[(o + 16 + l15) * 64 + o + ks * 4 + quad], Af[(o + ks * 4 + quad) * 64 + o + l15], accb, 0, 0, 0); else acc = __builtin_amdgcn_mfma_f32_16x16x4f32(Af[(o + 16 + l15) * 64 + o + ks * 4 + quad], Af[(o + ks * 4 + quad) * 64 + o + l15], acc, 0, 0, 0); }
        acc = acc + accb; accb = (f32x4){0.f, 0.f, 0.f, 0.f};
#pragma unroll
        for (int j = 0; j < 4; ++j) Zf[wave * 256 + (quad * 4 + j) * 16 + l15] = acc[j];
        asm volatile("s_waitcnt lgkmcnt(0)" ::: "memory");
        acc = (f32x4){0.f, 0.f, 0.f, 0.f};
#pragma unroll
        for (int ks = 0; ks < 4; ++ks) { if (ks & 1) accb = __builtin_amdgcn_mfma_f32_16x16x4f32(Af[(o + 16 + l15) * 64 + o + 16 + ks * 4 + quad], Zf[wave * 256 + (ks * 4 + quad) * 16 + l15], accb, 0, 0, 0); else acc = __builtin_amdgcn_mfma_f32_16x16x4f32(Af[(o + 16 + l15) * 64 + o + 16 + ks * 4 + quad], Zf[wave * 256 + (ks * 4 + quad) * 16 + l15], acc, 0, 0, 0); }
        acc = acc + accb; accb = (f32x4){0.f, 0.f, 0.f, 0.f};
#pragma unroll
        for (int j = 0; j < 4; ++j) Af[(o + 16 + quad * 4 + j) * 64 + o + l15] = -acc[j];
    }
    __syncthreads();
    const int ti = (wave >> 1) & 1, tj = wave & 1;
    if (wave < 4) {
        f32x4 acc = {0.f, 0.f, 0.f, 0.f}, accb = {0.f, 0.f, 0.f, 0.f};
#pragma unroll
        for (int ks = 0; ks < 8; ++ks) { if (ks & 1) accb = __builtin_amdgcn_mfma_f32_16x16x4f32(Af[(32 + ti * 16 + l15) * 64 + ks * 4 + quad], Af[(ks * 4 + quad) * 64 + tj * 16 + l15], accb, 0, 0, 0); else acc = __builtin_amdgcn_mfma_f32_16x16x4f32(Af[(32 + ti * 16 + l15) * 64 + ks * 4 + quad], Af[(ks * 4 + quad) * 64 + tj * 16 + l15], acc, 0, 0, 0); }
        acc = acc + accb; accb = (f32x4){0.f, 0.f, 0.f, 0.f};
#pragma unroll
        for (int j = 0; j < 4; ++j) Zf[(ti * 16 + quad * 4 + j) * 32 + tj * 16 + l15] = acc[j];
    }
    __syncthreads();
    if (wave < 4) {
        f32x4 acc = {0.f, 0.f, 0.f, 0.f}, accb = {0.f, 0.f, 0.f, 0.f};
#pragma unroll
        for (int ks = 0; ks < 8; ++ks) { if (ks & 1) accb = __builtin_amdgcn_mfma_f32_16x16x4f32(Af[(32 + ti * 16 + l15) * 64 + 32 + ks * 4 + quad], Zf[(ks * 4 + quad) * 32 + tj * 16 + l15], accb, 0, 0, 0); else acc = __builtin_amdgcn_mfma_f32_16x16x4f32(Af[(32 + ti * 16 + l15) * 64 + 32 + ks * 4 + quad], Zf[(ks * 4 + quad) * 32 + tj * 16 + l15], acc, 0, 0, 0); }
        acc = acc + accb; accb = (f32x4){0.f, 0.f, 0.f, 0.f};
#pragma unroll
        for (int j = 0; j < 4; ++j) Af[(32 + ti * 16 + quad * 4 + j) * 64 + tj * 16 + l15] = -acc[j];
    }
    __syncthreads();
    {   const int row = tid >> 3, c0 = (tid & 7) * 8;
        const f32x4 v0 = *(const f32x4*)(Af + row * 64 + c0), v1 = *(const f32x4*)(Af + row * 64 + c0 + 4);
        u32x4 w; w.x = cvt_pk_bf16(v0[0], v0[1]); w.y = cvt_pk_bf16(v0[2], v0[3]); w.z = cvt_pk_bf16(v1[0], v1[1]); w.w = cvt_pk_bf16(v1[2], v1[3]);
        *(u32x4*)(Tb + (row * 72 + c0) * 2) = w; }
    __syncthreads();
}
__device__ __forceinline__ bf16x8 gather8c(const unsigned char* base, int ld, int r0, int c0, int l15, int quad) {
    const int lo = (quad * 8 * ld + l15) * 2;
    bf16x8 g;
#pragma unroll
    for (int i = 0; i < 8; ++i) g[i] = *(const short*)(base + lo + ((r0 + i) * ld + c0) * 2);
    return g;
}

struct DnIn { u32x4 x[11]; float bb, aa; };
__device__ __forceinline__ void dn_load(const Params& p, int job, DnIn& in, int tid) {
    const bf16_t* P = (const bf16_t*)(p.ws + WS_P);
    const int bh = job / NCH, n = job % NCH, b = bh >> 3, h = bh & 7;
    in.bb = 0.f; in.aa = 0.f;
    if (tid < 64) { const int tp = n * 64 + tid - 48;
        if (tp >= 0) { const size_t m = (size_t)rowof(b, tp) * NP; in.bb = bf2f(P[m + C_DB + h]); in.aa = bf2f(P[m + C_DA + h]); } }
    const int grp = tid >> 4, g8 = tid & 15;
#pragma unroll
    for (int i = 0; i < 11; ++i) in.x[i] = (u32x4){0u, 0u, 0u, 0u};
    if (grp < 24) { const int which = grp >> 3, c0 = (grp & 7) * 8, chn = which * 1024 + h * 128 + g8 * 8, tp0 = n * 64 + c0 - 48;
#pragma unroll
        for (int i = 0; i < 11; ++i) { const int tpi = tp0 - 3 + i; if (tpi >= 0) in.x[i] = *(const u32x4*)(P + (size_t)rowof(b, tpi) * NP + C_DQ + chn); } }
}
__device__ __forceinline__ void dn_prep(const Params& p, int job, unsigned char* lds, DnIn& in, int next_job) {
    const int bh = job / NCH, n = job % NCH, b = bh >> 3, h = bh & 7;
    const int tid = opaque_tid(), lane = tid & 63, wave = tid >> 6, l15 = lane & 15, quad = lane >> 4;
    const bf16_t* P = (const bf16_t*)(p.ws + WS_P);
    unsigned char* blk = p.ws + WS_DNP + (size_t)job * DNP_BLK;
    bf16_t* gW = (bf16_t*)blk; bf16_t* gQG = (bf16_t*)(blk + 16384); bf16_t* gKDT = (bf16_t*)(blk + 32768); bf16_t* gAT = (bf16_t*)(blk + 49152); bf16_t* gU = (bf16_t*)(blk + 57344);
    unsigned char* Kn = lds; unsigned char* Kb = lds + 17408; unsigned char* Qs = lds + 34816; unsigned char* Vb = lds + 52224; unsigned char* Kbg = lds + 69632; unsigned char* Kd = lds + 87040;
    float* Mf = (float*)(lds + 104448); unsigned char* Tb = lds + 120832; float* Gs = (float*)(lds + 130048);
    if (tid < 64) {
        const int tp = n * 64 + tid - 48; float gl = 0.f, bt = 0.f;
        if (tp >= 0) { bt = sigmoidf_(in.bb); gl = -__expf(p.A_log[h]) * softplusf_(in.aa + p.dt_bias[h]); }
#pragma unroll
        for (int off = 1; off < 64; off <<= 1) { const float t = __shfl_up(gl, off); if (lane >= off) gl += t; }
        Gs[tid] = gl; Gs[64 + tid] = bt;
    }
    __syncthreads();
    const float glast = Gs[63];
    if (tid == 0) ((float*)(p.ws + WS_DNG))[job] = __expf(glast);
    {
        const int grp = tid >> 4, g8 = tid & 15;
        if (grp < 24) {
            const int which = grp >> 3, c0 = (grp & 7) * 8, chn = which * 1024 + h * 128 + g8 * 8, tp0 = n * 64 + c0 - 48;
            f32x4 cw[4][2];
#pragma unroll
            for (int i = 0; i < 4; ++i) { cw[i][0] = *(const f32x4*)(p.conv_w + (size_t)i * 3072 + chn); cw[i][1] = *(const f32x4*)(p.conv_w + (size_t)i * 3072 + chn + 4); }
#pragma unroll
            for (int cc = 0; cc < 8; ++cc) {
                const int c = c0 + cc; float acc[8];
#pragma unroll
                for (int e = 0; e < 8; ++e) acc[e] = 0.f;
#pragma unroll
                for (int i = 0; i < 4; ++i) { const u32x4 xv = in.x[cc + i];
                    acc[0] += cw[i][0][0] * bf_lo(xv.x); acc[1] += cw[i][0][1] * bf_hi(xv.x); acc[2] += cw[i][0][2] * bf_lo(xv.y); acc[3] += cw[i][0][3] * bf_hi(xv.y);
                    acc[4] += cw[i][1][0] * bf_lo(xv.z); acc[5] += cw[i][1][1] * bf_hi(xv.z); acc[6] += cw[i][1][2] * bf_lo(xv.w); acc[7] += cw[i][1][3] * bf_hi(xv.w); }
                if (tp0 >= 0) {
#pragma unroll
                    for (int e = 0; e < 8; ++e) acc[e] = siluf_(acc[e]); }
                else {
#pragma unroll
                    for (int e = 0; e < 8; ++e) acc[e] = 0.f; }
                float ss = 0.f;
#pragma unroll
                for (int e = 0; e < 8; ++e) ss += acc[e] * acc[e];
                ss = sum16(ss);
                const float inv = rsqrtf(ss + 1e-6f);
                const float gc = Gs[c], bt = Gs[64 + c];
                const int lo = (c * 136 + g8 * 8) * 2;
#define PK8(dstp, sc) do { const float _s = (sc); u32x4 _w; _w.x = cvt_pk_bf16(acc[0] * _s, acc[1] * _s); _w.y = cvt_pk_bf16(acc[2] * _s, acc[3] * _s); \
        _w.z = cvt_pk_bf16(acc[4] * _s, acc[5] * _s); _w.w = cvt_pk_bf16(acc[6] * _s, acc[7] * _s); *(u32x4*)(dstp) = _w; } while (0)
                if (which == 0) { const float sc = inv * 0.08838834764831845f; PK8(Qs + lo, sc); PK8(gQG + c * 128 + g8 * 8, sc * __expf(gc)); }
                else if (which == 1) { PK8(Kn + lo, inv); PK8(Kb + lo, inv * bt); PK8(Kbg + lo, inv * bt * __expf(gc)); PK8(Kd + lo, inv * __expf(glast - gc)); }
                else { PK8(Vb + lo, bt); }
#undef PK8
            }
        }
    }
    if (next_job >= 0) dn_load(p, next_job, in, tid);
    __syncthreads();
#pragma unroll 1
    for (int i = 0; i < 4; ++i) {
        const int tile = wave * 4 + i;
        f32x4 acc = {0.f, 0.f, 0.f, 0.f};
        if (tile < 16) { const int ct = tile >> 2, st = tile & 3;
            bf16x8 fa[4], fb[4]; f32x4 acc2 = {0.f, 0.f, 0.f, 0.f};
#pragma unroll
            for (int ks = 0; ks < 4; ++ks) { fa[ks] = ldfrag(Kb, 136, ct * 16, ks * 32, lane); fb[ks] = ldfrag(Kn, 136, st * 16, ks * 32, lane); }
            acc = MFMA16(fa[0], fb[0], acc); acc2 = MFMA16(fa[1], fb[1], acc2); acc = MFMA16(fa[2], fb[2], acc); acc2 = MFMA16(fa[3], fb[3], acc2);
            acc = acc + acc2;
            const int s = st * 16 + l15; const float gs = Gs[s];
#pragma unroll
            for (int j = 0; j < 4; ++j) { const int c = ct * 16 + quad * 4 + j; Mf[c * 64 + s] = (s < c) ? acc[j] * __expf(Gs[c] - gs) : 0.f; }
        } else { const int t2 = tile - 16, st = t2 >> 2, ct = t2 & 3;
            bf16x8 fa[4], fb[4]; f32x4 acc2 = {0.f, 0.f, 0.f, 0.f};
#pragma unroll
            for (int ks = 0; ks < 4; ++ks) { fa[ks] = ldfrag(Kn, 136, st * 16, ks * 32, lane); fb[ks] = ldfrag(Qs, 136, ct * 16, ks * 32, lane); }
            acc = MFMA16(fa[0], fb[0], acc); acc2 = MFMA16(fa[1], fb[1], acc2); acc = MFMA16(fa[2], fb[2], acc); acc2 = MFMA16(fa[3], fb[3], acc2);
            acc = acc + acc2;
            const int c = ct * 16 + l15; const float gc = Gs[c]; float v[4];
#pragma unroll
            for (int j = 0; j < 4; ++j) { const int s = st * 16 + quad * 4 + j; v[j] = (s <= c) ? acc[j] * __expf(gc - Gs[s]) : 0.f; }
            *(u32x2*)(gAT + c * 64 + st * 16 + quad * 4) = (u32x2){cvt_pk_bf16(v[0], v[1]), cvt_pk_bf16(v[2], v[3])};
        }
    }
    __syncthreads();
    inverse64(Mf, (float*)(lds + 130560), Tb, tid);
    {
        const int dt = wave;
        bf16x8 GV[2], GK[2];
#pragma unroll
        for (int ks = 0; ks < 2; ++ks)
#pragma unroll
            for (int i = 0; i < 8; ++i) { const int lo = (quad * 8 * 136 + dt * 16 + l15) * 2, off = (ks * 32 + i) * 136 * 2;
                GV[ks][i] = *(const short*)(Vb + lo + off); GK[ks][i] = *(const short*)(Kbg + lo + off); }
        bf16x8 tfr[4][2]; f32x4 aus[4], aws[4];
#pragma unroll
        for (int ct = 0; ct < 4; ++ct) { tfr[ct][0] = ldfrag(Tb, 72, ct * 16, 0, lane); tfr[ct][1] = ldfrag(Tb, 72, ct * 16, 32, lane); }
#pragma unroll
        for (int ct = 0; ct < 4; ++ct) { aus[ct] = MFMA16(tfr[ct][0], GV[0], ((f32x4){0.f, 0.f, 0.f, 0.f})); aws[ct] = MFMA16(GK[0], tfr[ct][0], ((f32x4){0.f, 0.f, 0.f, 0.f})); }
#pragma unroll
        for (int ct = 0; ct < 4; ++ct) { aus[ct] = MFMA16(tfr[ct][1], GV[1], aus[ct]); aws[ct] = MFMA16(GK[1], tfr[ct][1], aws[ct]); }
#pragma unroll
        for (int ct = 0; ct < 4; ++ct) {
            const f32x4 au = aus[ct], aw = aws[ct];
            *(u32x2*)(gU + ((ct * 8 + dt) * 64 + lane) * 4) = (u32x2){cvt_pk_bf16(au[0], au[1]), cvt_pk_bf16(au[2], au[3])};
            *(u32x2*)(gW + (ct * 16 + l15) * 128 + dt * 16 + quad * 4) = (u32x2){cvt_pk_bf16(-aw[0], -aw[1]), cvt_pk_bf16(-aw[2], -aw[3])};
        }
        const int k = tid & 127, cbq = tid >> 7;
#pragma unroll
        for (int rr = 0; rr < 2; ++rr) { const int cb = cbq + rr * 4; unsigned v[8];
#pragma unroll
            for (int i = 0; i < 8; ++i) v[i] = *(const bf16_t*)(Kd + ((cb * 8 + i) * 136 + k) * 2);
            u32x4 w; w.x = v[0] | (v[1] << 16); w.y = v[2] | (v[3] << 16); w.z = v[4] | (v[5] << 16); w.w = v[6] | (v[7] << 16);
            *(u32x4*)(gKDT + k * 64 + cb * 8) = w; }
    }
    __syncthreads();
}

constexpr int DN_PARTS = 4, DN_VPW = 8 / DN_PARTS;
constexpr size_t DN_ORAW_OFF = (size_t)64 << 20;
struct DnSet { u32x4 pw[2], pq[2], pk[2], pa; u32x2 pu[4]; float dec; };
__device__ __forceinline__ void dn_fetch(const Params& p, DnSet& s, int bh, int n, int tid, int vt, int lane) {
    const unsigned char* blk = p.ws + WS_DNP + (size_t)(bh * NCH + n) * DNP_BLK;
#pragma unroll
    for (int i = 0; i < 2; ++i) { const int id = tid + 512 * i; s.pw[i] = *(const u32x4*)(blk + id * 16); s.pq[i] = *(const u32x4*)(blk + 16384 + id * 16); s.pk[i] = *(const u32x4*)(blk + 32768 + id * 16); }
    s.pa = *(const u32x4*)(blk + 49152 + tid * 16);
#pragma unroll
    for (int ct = 0; ct < 4; ++ct) s.pu[ct] = *(const u32x2*)(blk + 57344 + (((ct * 8 + vt) * 64 + lane) * 8));
    s.dec = ((const float*)(p.ws + WS_DNG))[bh * NCH + n];
}
__device__ __forceinline__ void dn_chunk(const Params& p, DnSet& s, f32x4 (&S)[8], int bh, int n, int tid, int wave, int lane, int l15, int quad, bool mf, int vt, unsigned char* lds) {
    unsigned char* Wl = lds; unsigned char* QGl = lds + 17408; unsigned char* KDl = lds + 34816; unsigned char* ATl = lds + 53248;
    unsigned char* St = lds + 62464 + (wave & (DN_VPW - 1)) * 4352; unsigned char* Vt = lds + 97280 + (wave & (DN_VPW - 1)) * 2304;
    __syncthreads();
#pragma unroll
    for (int i = 0; i < 2; ++i) { const int id = tid + 512 * i;
        *(u32x4*)(Wl + ((id >> 4) * 136 + (id & 15) * 8) * 2) = s.pw[i]; *(u32x4*)(QGl + ((id >> 4) * 136 + (id & 15) * 8) * 2) = s.pq[i];
        *(u32x4*)(KDl + ((id >> 3) * 72 + (id & 7) * 8) * 2) = s.pk[i]; }
    *(u32x4*)(ATl + ((tid >> 3) * 72 + (tid & 7) * 8) * 2) = s.pa;
    f32x4 vn[4];
#pragma unroll
    for (int ct = 0; ct < 4; ++ct) vn[ct] = (f32x4){bf_lo(s.pu[ct].x), bf_hi(s.pu[ct].x), bf_lo(s.pu[ct].y), bf_hi(s.pu[ct].y)};
    const float dec = s.dec;
    __syncthreads();
    if (n + 2 < NCH) dn_fetch(p, s, bh, n + 2, tid, vt, lane);
    {
        unsigned char* ogl = (unsigned char*)p.out + DN_ORAW_OFF + (size_t)(bh * NCH + n) * 16384;
        if (mf) {
#pragma unroll
        for (int kt = 0; kt < 8; ++kt) *(u32x2*)(St + (l15 * 136 + kt * 16 + quad * 4) * 2) = (u32x2){cvt_pk_bf16(S[kt][0], S[kt][1]), cvt_pk_bf16(S[kt][2], S[kt][3])};
        asm volatile("s_waitcnt lgkmcnt(0)" ::: "memory");
        bf16x8 sf[4];
#pragma unroll
        for (int ks = 0; ks < 4; ++ks) sf[ks] = ldfrag(St, 136, 0, ks * 32, lane);
        {   bf16x8 fa[4], fb[4];
#pragma unroll
            for (int ct = 0; ct < 4; ++ct) fa[ct] = ldfrag(Wl, 136, ct * 16, 0, lane);
#pragma unroll
            for (int ks = 0; ks < 4; ++ks) {
                if (ks + 1 < 4) {
#pragma unroll
                    for (int ct = 0; ct < 4; ++ct) { if (ks & 1) fa[ct] = ldfrag(Wl, 136, ct * 16, (ks + 1) * 32, lane); else fb[ct] = ldfrag(Wl, 136, ct * 16, (ks + 1) * 32, lane); } }
#pragma unroll
                for (int ct = 0; ct < 4; ++ct) vn[ct] = MFMA16((ks & 1) ? fb[ct] : fa[ct], sf[ks], vn[ct]);
            } }
#pragma unroll
        for (int ct = 0; ct < 4; ++ct) *(u32x2*)(Vt + (l15 * 72 + ct * 16 + quad * 4) * 2) = (u32x2){cvt_pk_bf16(vn[ct][0], vn[ct][1]), cvt_pk_bf16(vn[ct][2], vn[ct][3])};
        asm volatile("s_waitcnt lgkmcnt(0)" ::: "memory");
        bf16x8 vf[2];
#pragma unroll
        for (int ks = 0; ks < 2; ++ks) vf[ks] = ldfrag(Vt, 72, 0, ks * 32, lane);
        {   f32x4 o[4]; bf16x8 fa[4], fb[4];
#pragma unroll
            for (int ct = 0; ct < 4; ++ct) { o[ct] = (f32x4){0.f, 0.f, 0.f, 0.f}; fa[ct] = ldfrag(QGl, 136, ct * 16, 0, lane); }
#pragma unroll
            for (int ks = 0; ks < 6; ++ks) {
                if (ks + 1 < 6) {
#pragma unroll
                    for (int ct = 0; ct < 4; ++ct) { const bf16x8 f = (ks + 1 < 4) ? ldfrag(QGl, 136, ct * 16, (ks + 1) * 32, lane) : ldfrag(ATl, 72, ct * 16, (ks + 1 - 4) * 32, lane);
                        if (ks & 1) fa[ct] = f; else fb[ct] = f; } }
#pragma unroll
                for (int ct = 0; ct < 4; ++ct) o[ct] = MFMA16(ks < 4 ? sf[ks] : vf[ks - 4], (ks & 1) ? fb[ct] : fa[ct], o[ct]);
            }
#pragma unroll
            for (int ct = 0; ct < 4; ++ct)
                *(u32x2*)(ogl + ((ct * 16 + l15) * 128 + vt * 16 + quad * 4) * 2) = (u32x2){cvt_pk_bf16(o[ct][0], o[ct][1]), cvt_pk_bf16(o[ct][2], o[ct][3])}; }
        {   bf16x8 fa[8], fb[8];
#pragma unroll
            for (int kt = 0; kt < 8; ++kt) { fa[kt] = ldfrag(KDl, 72, kt * 16, 0, lane); S[kt] = S[kt] * dec; }
#pragma unroll
            for (int kt = 0; kt < 8; ++kt) fb[kt] = ldfrag(KDl, 72, kt * 16, 32, lane);
#pragma unroll
            for (int kt = 0; kt < 8; ++kt) S[kt] = MFMA16(fa[kt], vf[0], S[kt]);
#pragma unroll
            for (int kt = 0; kt < 8; ++kt) S[kt] = MFMA16(fb[kt], vf[1], S[kt]);
        }
        }
    }
}
__device__ __forceinline__ void dn_scan(const Params& p, int bh, int part, unsigned char* lds) {
    const int tid = opaque_tid(), lane = tid & 63, wave = tid >> 6, l15 = lane & 15, quad = lane >> 4;
    const bool mf = wave < DN_VPW; const int vt = part * DN_VPW + (wave & (DN_VPW - 1));
    f32x4 S[8];
#pragma unroll
    for (int i = 0; i < 8; ++i) S[i] = (f32x4){0.f, 0.f, 0.f, 0.f};
    DnSet s0, s1;
    dn_fetch(p, s0, bh, 0, tid, vt, lane);
    dn_fetch(p, s1, bh, 1, tid, vt, lane);
#pragma unroll 1
    for (int n = 0; n + 3 < NCH; n += 4) {
        dn_chunk(p, s0, S, bh, n, tid, wave, lane, l15, quad, mf, vt, lds);
        dn_chunk(p, s1, S, bh, n + 1, tid, wave, lane, l15, quad, mf, vt, lds);
        dn_chunk(p, s0, S, bh, n + 2, tid, wave, lane, l15, quad, mf, vt, lds);
        dn_chunk(p, s1, S, bh, n + 3, tid, wave, lane, l15, quad, mf, vt, lds);
    }
    static_assert(NCH % 4 == 1, "tail below handles exactly one chunk");
    dn_chunk(p, s0, S, bh, NCH - 1, tid, wave, lane, l15, quad, mf, vt, lds);
}


struct DnPostIn { u32x4 o0, o1, z0, z1; };
__device__ __forceinline__ void dn_post_load(const Params& p, int job, DnPostIn& in, int tid) {
    const int bh = job / NCH, n = job % NCH, b = bh >> 3, h = bh & 7;
    const int pc = tid >> 3, pvg = tid & 7, tp = n * 64 + pc - 48;
    const bf16_t* P = (const bf16_t*)(p.ws + WS_P);
    const unsigned char* op = (const unsigned char*)p.out + DN_ORAW_OFF + (size_t)job * 16384 + (pc * 128 + pvg * 16) * 2;
    const bf16_t* zp = P + (size_t)rowof(b, tp < 0 ? 0 : tp) * NP + C_Z + h * 128 + pvg * 16;
    in.o0 = ((const u32x4*)op)[0]; in.o1 = ((const u32x4*)op)[1]; in.z0 = ((const u32x4*)zp)[0]; in.z1 = ((const u32x4*)zp)[1];
}
__device__ __forceinline__ void dn_post(const Params& p, int job, const DnPostIn& in, int tid) {
    const int bh = job / NCH, n = job % NCH, b = bh >> 3, h = bh & 7;
    const int pc = tid >> 3, pvg = tid & 7, tp = n * 64 + pc - 48;
    bf16_t* P = (bf16_t*)(p.ws + WS_P);
    const bool valid = tp >= 0;
    bf16_t* zp = P + (size_t)rowof(b, valid ? tp : 0) * NP + C_Z + h * 128 + pvg * 16;
    const u32x4 o0 = in.o0, o1 = in.o1, z0 = in.z0, z1 = in.z1;
    const f32x4 nw0 = *(const f32x4*)(p.dn_norm_w + pvg * 16), nw1 = *(const f32x4*)(p.dn_norm_w + pvg * 16 + 4), nw2 = *(const f32x4*)(p.dn_norm_w + pvg * 16 + 8), nw3 = *(const f32x4*)(p.dn_norm_w + pvg * 16 + 12);
    const float nw[16] = {nw0[0], nw0[1], nw0[2], nw0[3], nw1[0], nw1[1], nw1[2], nw1[3], nw2[0], nw2[1], nw2[2], nw2[3], nw3[0], nw3[1], nw3[2], nw3[3]};
    float ov[16], zv[16];
#pragma unroll
    for (int e = 0; e < 4; ++e) { ov[2 * e] = bf_lo(o0[e]); ov[2 * e + 1] = bf_hi(o0[e]); ov[8 + 2 * e] = bf_lo(o1[e]); ov[8 + 2 * e + 1] = bf_hi(o1[e]);
        zv[2 * e] = bf_lo(z0[e]); zv[2 * e + 1] = bf_hi(z0[e]); zv[8 + 2 * e] = bf_lo(z1[e]); zv[8 + 2 * e + 1] = bf_hi(z1[e]); }
    float ss = 0.f;
#pragma unroll
    for (int e = 0; e < 16; ++e) ss += ov[e] * ov[e];
    ss = sum8(ss);
    const float inv = rsqrtf(ss * (1.f / 128.f) + 1e-6f);
    float r[16];
#pragma unroll
    for (int e = 0; e < 16; ++e) r[e] = ov[e] * inv * nw[e] * siluf_(zv[e]);
    if (valid) { u32x4 w0, w1;
        w0.x = cvt_pk_bf16(r[0], r[1]); w0.y = cvt_pk_bf16(r[2], r[3]); w0.z = cvt_pk_bf16(r[4], r[5]); w0.w = cvt_pk_bf16(r[6], r[7]);
        w1.x = cvt_pk_bf16(r[8], r[9]); w1.y = cvt_pk_bf16(r[10], r[11]); w1.z = cvt_pk_bf16(r[12], r[13]); w1.w = cvt_pk_bf16(r[14], r[15]);
        ((u32x4*)zp)[0] = w0; ((u32x4*)zp)[1] = w1; }
}

constexpr size_t RWP_BLK = 33792;
constexpr int RWP_SPLIT = 2296;
__device__ __forceinline__ unsigned char* rwp_ptr(const Params& p, int job) {
    return job < RWP_SPLIT ? p.ws + WS_RWP + (size_t)job * RWP_BLK : (unsigned char*)p.out + (size_t)(job - RWP_SPLIT) * RWP_BLK;
}
#define PACK4(a) ((u32x2){cvt_pk_bf16((a)[0], (a)[1]), cvt_pk_bf16((a)[2], (a)[3])})


struct RwIn { u32x4 lc[2], lq[2], cr, ck, cv, qr, qk, qv; bf16x8 A1[2], A2[2]; f32x4 w0v, a0v; f32x4 mul[4]; };
__device__ __forceinline__ void rw_load(const Params& p, int job, RwIn& in, int tid) {
    const bf16_t* P = (const bf16_t*)(p.ws + WS_P);
    const int bh = job / NCH, n = job % NCH, b = bh >> 4, h = bh & 15;
    const u32x4 z = {0u, 0u, 0u, 0u};
    in.lc[0] = z; in.lc[1] = z; in.lq[0] = z; in.lq[1] = z; in.cr = z; in.ck = z; in.cv = z; in.qr = z; in.qk = z; in.qv = z;
    const int tp = n * 64 + (tid >> 3) - 48, cs = (tid & 7) * 16, chn3 = h * 64 + (tid & 7) * 8;
    {
        const int lane = tid & 63, wave = tid >> 6, l15 = lane & 15, quad = lane >> 4, chl = (wave & 3) * 16;
        const bf16_t* W2T = (const bf16_t*)(p.ws + WS_W2T); const bf16_t* A2T = (const bf16_t*)(p.ws + WS_A2T);
#pragma unroll
        for (int ks = 0; ks < 2; ++ks) { in.A1[ks] = *(const bf16x8*)(W2T + (size_t)(h * 64 + chl + l15) * 64 + ks * 32 + quad * 8); in.A2[ks] = *(const bf16x8*)(A2T + (size_t)(h * 64 + chl + l15) * 64 + ks * 32 + quad * 8); }
        const int ch = h * 64 + chl + quad * 4;
        in.w0v = *(const f32x4*)(p.w0 + ch); in.a0v = *(const f32x4*)(p.a0 + ch);
    }
    if (tp >= 0) {
        const bf16_t* rp = P + (size_t)rowof(b, tp) * NP;
        in.lc[0] = *(const u32x4*)(rp + C_LW + cs); in.lc[1] = *(const u32x4*)(rp + C_LW + cs + 8);
        in.cr = *(const u32x4*)(rp + chn3 + C_R); in.ck = *(const u32x4*)(rp + chn3 + C_K); in.cv = *(const u32x4*)(rp + chn3 + C_V);
        if (tp > 0) { const bf16_t* pp = P + (size_t)rowof(b, tp - 1) * NP;
            in.lq[0] = *(const u32x4*)(pp + C_LW + cs); in.lq[1] = *(const u32x4*)(pp + C_LW + cs + 8);
            in.qr = *(const u32x4*)(pp + chn3 + C_R); in.qk = *(const u32x4*)(pp + chn3 + C_K); in.qv = *(const u32x4*)(pp + chn3 + C_V); } }
}
__device__ __forceinline__ void rw_prep(const Params& p, int job, unsigned char* lds, RwIn& in, int next_job) {
    const int bh = job / NCH, n = job % NCH, b = bh >> 4, h = bh & 15;
    const int tid = opaque_tid(), lane = tid & 63, wave = tid >> 6, l15 = lane & 15, quad = lane >> 4;
    const bf16_t* P = (const bf16_t*)(p.ws + WS_P);
    unsigned char* blk = rwp_ptr(p, job);
    bf16_t* gQ = (bf16_t*)blk; bf16_t* gF = (bf16_t*)(blk + 8192); bf16_t* gY0 = (bf16_t*)(blk + 16384); bf16_t* gS0 = (bf16_t*)(blk + 24576);
    float* gWC = (float*)(blk + 32768); float* gBS = (float*)(blk + 33024);
    unsigned char* sKap = lds; unsigned char* sBet = lds + 9216; unsigned char* sKti = lds + 18432; unsigned char* sRho = lds + 27648; unsigned char* sBd = lds + 36864;
    unsigned char* sKd = lds + 46080; unsigned char* sV = lds + 55296; unsigned char* sBm = lds + 64512; unsigned char* sAb = lds + 73728; unsigned char* sAk = lds + 82944; unsigned char* sT = lds + 92160;
    unsigned char* sP1 = sBet; unsigned char* sX = sKti; unsigned char* sP2 = sBm;
    float* Af = (float*)(lds + 101376);
    float* AA = (float*)(lds + 64512);
    float* Zf = (float*)(lds + 117760);
    unsigned char* X1 = lds + 121856; unsigned char* X2 = lds + 131072;
    float* WC = (float*)(lds + 140288);
    const int t3 = tid >> 3, c8 = (tid & 7) * 8, chn3 = h * 64 + c8;
    f32x4 cmr[2], cmk[2], cmv[2], ckk[2], cka[2], crk[2];
#pragma unroll
    for (int i = 0; i < 2; ++i) { cmr[i] = *(const f32x4*)(p.mu + C_R + chn3 + 4 * i); cmk[i] = *(const f32x4*)(p.mu + C_K + chn3 + 4 * i); cmv[i] = *(const f32x4*)(p.mu + C_V + chn3 + 4 * i);
        ckk[i] = *(const f32x4*)(p.k_k + chn3 + 4 * i); cka[i] = *(const f32x4*)(p.k_a + chn3 + 4 * i); crk[i] = *(const f32x4*)(p.r_k + chn3 + 4 * i); }
    {
        const int tok = tid >> 3, cs = (tid & 7) * 16;
        const u32x4 c[2] = {in.lc[0], in.lc[1]}, q[2] = {in.lq[0], in.lq[1]};
        float v[16];
#pragma unroll
        for (int i = 0; i < 2; ++i)
#pragma unroll
            for (int e = 0; e < 4; ++e) { const unsigned cw = c[i][e], qw = q[i][e];
                const float c0 = bf_lo(cw), c1 = bf_hi(cw), q0 = bf_lo(qw), q1 = bf_hi(qw);
                const int idx = i * 8 + e * 2; const float mu0 = in.mul[idx >> 2][idx & 3], mu1 = in.mul[(idx + 1) >> 2][(idx + 1) & 3];
                v[idx] = c0 + (q0 - c0) * mu0; v[idx + 1] = c1 + (q1 - c1) * mu1; }
        if (cs < 64) {
#pragma unroll
            for (int i = 0; i < 16; ++i) { const float e2 = __expf(2.f * v[i]); v[i] = 1.f - 2.f * __builtin_amdgcn_rcpf(e2 + 1.f); } }
        unsigned char* dst = (cs < 64 ? X1 : X2) + (tok * 72 + (cs & 63)) * 2;
        u32x4 w0, w1;
        w0.x = cvt_pk_bf16(v[0], v[1]); w0.y = cvt_pk_bf16(v[2], v[3]); w0.z = cvt_pk_bf16(v[4], v[5]); w0.w = cvt_pk_bf16(v[6], v[7]);
        w1.x = cvt_pk_bf16(v[8], v[9]); w1.y = cvt_pk_bf16(v[10], v[11]); w1.z = cvt_pk_bf16(v[12], v[13]); w1.w = cvt_pk_bf16(v[14], v[15]);
        ((u32x4*)dst)[0] = w0; ((u32x4*)dst)[1] = w1;
    }
    __syncthreads();
    {
        const int chl = (wave & 3) * 16, tt0 = (wave >> 2) * 2;
        const bf16x8 A1[2] = {in.A1[0], in.A1[1]}, A2[2] = {in.A2[0], in.A2[1]}; const f32x4 w0v = in.w0v, a0v = in.a0v;
        bf16x8 xf1[2][2], xf2[2][2];
#pragma unroll
        for (int q = 0; q < 2; ++q)
#pragma unroll
            for (int ks = 0; ks < 2; ++ks) { xf1[q][ks] = ldfrag(X1, 72, (tt0 + q) * 16, ks * 32, lane); xf2[q][ks] = ldfrag(X2, 72, (tt0 + q) * 16, ks * 32, lane); }
#pragma unroll
        for (int q = 0; q < 2; ++q) { const int tt = tt0 + q;
            f32x4 acc1 = {0.f, 0.f, 0.f, 0.f}, acc2 = {0.f, 0.f, 0.f, 0.f};
#pragma unroll
            for (int ks = 0; ks < 2; ++ks) { acc1 = MFMA16(A1[ks], xf1[q][ks], acc1); acc2 = MFMA16(A2[ks], xf2[q][ks], acc2); }
            const int tok = tt * 16 + l15; const bool nul = (n * 64 + tok - 48) < 0;
            f32x4 ew, av;
#pragma unroll
            for (int j = 0; j < 4; ++j) { ew[j] = nul ? 0.f : 0.6065306597f * sigmoidf_(w0v[j] + acc1[j]); av[j] = sigmoidf_(a0v[j] + acc2[j]); }
            *(f32x4*)(Af + tok * 64 + chl + quad * 4) = ew; *(f32x4*)(AA + tok * 64 + chl + quad * 4) = av;
        }
    }
    __syncthreads();
    {
        const int ch = tid & 63, seg = tid >> 6;
        float e[8], s = 0.f;
#pragma unroll
        for (int i = 0; i < 8; ++i) { e[i] = Af[(seg * 8 + i) * 64 + ch]; s += e[i]; }
        Zf[seg * 64 + ch] = s;
        __syncthreads();
        float pre = 0.f;
#pragma unroll
        for (int s2 = 0; s2 < 7; ++s2) pre += (s2 < seg) ? Zf[s2 * 64 + ch] : 0.f;
#pragma unroll
        for (int i = 0; i < 8; ++i) { pre += e[i]; Af[(seg * 8 + i) * 64 + ch] = -pre; }
        if (seg == 7) { const float wc = __expf(-pre); WC[ch] = wc; gWC[ch] = wc; }
    }
    __syncthreads();
    {
        const int t = t3;
        const u32x4 cr = in.cr, ck = in.ck, cv = in.cv, qr = in.qr, qk = in.qk, qv = in.qv;
        float r[8], k[8], v[8];
#pragma unroll
        for (int e = 0; e < 4; ++e) {
            const int i = e >> 1, j0 = (2 * e) & 3;
            float c0 = bf_lo(cr[e]), c1 = bf_hi(cr[e]); r[2 * e] = c0 + (bf_lo(qr[e]) - c0) * cmr[i][j0]; r[2 * e + 1] = c1 + (bf_hi(qr[e]) - c1) * cmr[i][j0 + 1];
            c0 = bf_lo(ck[e]); c1 = bf_hi(ck[e]); k[2 * e] = c0 + (bf_lo(qk[e]) - c0) * cmk[i][j0]; k[2 * e + 1] = c1 + (bf_hi(qk[e]) - c1) * cmk[i][j0 + 1];
            c0 = bf_lo(cv[e]); c1 = bf_hi(cv[e]); v[2 * e] = c0 + (bf_lo(qv[e]) - c0) * cmv[i][j0]; v[2 * e + 1] = c1 + (bf_hi(qv[e]) - c1) * cmv[i][j0 + 1]; }
        float kn[8], km[8], bb[8], ss = 0.f, bs = 0.f;
#pragma unroll
        for (int e = 0; e < 8; ++e) { const float a = AA[t * 64 + c8 + e]; kn[e] = k[e] * ckk[e >> 2][e & 3]; ss += kn[e] * kn[e];
            km[e] = k[e] * (1.f + (a - 1.f) * cka[e >> 2][e & 3]); bb[e] = a; bs += r[e] * km[e] * crk[e >> 2][e & 3]; }
        ss = sum8(ss); bs = sum8(bs);
        const float inv = rsqrtf(ss + 1e-6f);
        if ((tid & 7) == 0) gBS[t] = bs;
        float oKap[8], oBet[8], oKti[8], oRho[8], oBd[8], oKd[8];
#pragma unroll
        for (int e = 0; e < 8; ++e) { kn[e] *= inv; bb[e] *= kn[e];
            const float g = Af[t * 64 + c8 + e], gp = t > 0 ? Af[(t - 1) * 64 + c8 + e] : 0.f, gl = Af[63 * 64 + c8 + e];
            const float eg = __expf(g), ing = __expf(-g), egl = __expf(gl - g);
            oKap[e] = kn[e] * __expf(gp); oBet[e] = bb[e] * ing; oKti[e] = km[e] * ing; oRho[e] = r[e] * eg; oBd[e] = bb[e] * egl; oKd[e] = km[e] * egl; }
        const int lo = (t * 72 + c8) * 2;
#define ST8(dstp, a) do { u32x4 _w; _w.x = cvt_pk_bf16((a)[0], (a)[1]); _w.y = cvt_pk_bf16((a)[2], (a)[3]); _w.z = cvt_pk_bf16((a)[4], (a)[5]); _w.w = cvt_pk_bf16((a)[6], (a)[7]); *(u32x4*)(dstp) = _w; } while (0)
        ST8(sKap + lo, oKap); ST8(sBet + lo, oBet); ST8(sKti + lo, oKti); ST8(sRho + lo, oRho);
#define STT(base, a) do { _Pragma("unroll") for (int e_ = 0; e_ < 8; e_ += 2) { const unsigned w_ = cvt_pk_bf16((a)[e_], (a)[e_ + 1]); \
            *(bf16_t*)((base) + ((c8 + e_) * 72 + t) * 2) = (bf16_t)(w_ & 0xffffu); *(bf16_t*)((base) + ((c8 + e_ + 1) * 72 + t) * 2) = (bf16_t)(w_ >> 16); } } while (0)
        STT(X1, oKap); STT(sBd, oBd); STT(sKd, oKd); STT(sV, v);
#undef STT
#undef ST8
    }
    if (next_job >= 0) rw_load(p, next_job, in, tid);
    __syncthreads();
    {
        const int pidx = wave >> 1, tt0 = (wave & 1) * 2;
        const unsigned char* Xop = (pidx < 2) ? sKap : sRho; const unsigned char* Yop = (pidx & 1) ? sKti : sBet;
        unsigned char* dstb = pidx == 1 ? sBm : (pidx == 2 ? sAb : sAk);
#pragma unroll
        for (int q = 0; q < 2; ++q) { const int tt = tt0 + q, t = tt * 16 + l15;
            const bf16x8 x0 = ldfrag(Xop, 72, tt * 16, 0, lane), x1 = ldfrag(Xop, 72, tt * 16, 32, lane);
            bf16x8 yf[4][2]; f32x4 accs[4];
#pragma unroll
            for (int it = 0; it < 4; ++it) { yf[it][0] = ldfrag(Yop, 72, it * 16, 0, lane); yf[it][1] = ldfrag(Yop, 72, it * 16, 32, lane); }
#pragma unroll
            for (int it = 0; it < 4; ++it) accs[it] = MFMA16(yf[it][0], x0, ((f32x4){0.f, 0.f, 0.f, 0.f}));
#pragma unroll
            for (int it = 0; it < 4; ++it) accs[it] = MFMA16(yf[it][1], x1, accs[it]);
#pragma unroll
            for (int it = 0; it < 4; ++it) { f32x4 acc = accs[it];
                const int i0 = it * 16 + quad * 4;
#pragma unroll
                for (int j = 0; j < 4; ++j) { const bool keep = (pidx < 2) ? (i0 + j < t) : (i0 + j <= t); acc[j] = keep ? acc[j] : 0.f; }
                if (pidx == 0) *(f32x4*)(Af + t * 64 + i0) = acc; else *(u32x2*)(dstb + (t * 72 + i0) * 2) = PACK4(acc);
            } }
    }
    __syncthreads();
    inverse64(Af, Zf, sT, tid);
    {
        const int prod = wave >> 2, ct = wave & 3;
        const unsigned char* Asrc = prod ? sBm : sT; const unsigned char* Bsrc = prod ? sV : X1; unsigned char* dst = prod ? sX : sP1;
        const bf16x8 b0 = ldfrag(Bsrc, 72, ct * 16, 0, lane), b1 = ldfrag(Bsrc, 72, ct * 16, 32, lane);
        bf16x8 af[4][2]; f32x4 accs[4];
#pragma unroll
        for (int tt = 0; tt < 4; ++tt) { af[tt][0] = ldfrag(Asrc, 72, tt * 16, 0, lane); af[tt][1] = ldfrag(Asrc, 72, tt * 16, 32, lane); }
#pragma unroll
        for (int tt = 0; tt < 4; ++tt) accs[tt] = MFMA16(af[tt][0], b0, ((f32x4){0.f, 0.f, 0.f, 0.f}));
#pragma unroll
        for (int tt = 0; tt < 4; ++tt) accs[tt] = MFMA16(af[tt][1], b1, accs[tt]);
#pragma unroll
        for (int tt = 0; tt < 4; ++tt) *(u32x2*)(dst + ((ct * 16 + l15) * 72 + tt * 16 + quad * 4) * 2) = PACK4(accs[tt]);
    }
    __syncthreads();
    {
        const int vt = wave & 3, tt0 = (wave >> 2) * 2;
        const bf16x8 b0 = ldfrag(sX, 72, vt * 16, 0, lane), b1 = ldfrag(sX, 72, vt * 16, 32, lane);
        f32x4 acc[2]; bf16x8 tf[2][2];
#pragma unroll
        for (int q = 0; q < 2; ++q) { tf[q][0] = ldfrag(sT, 72, (tt0 + q) * 16, 0, lane); tf[q][1] = ldfrag(sT, 72, (tt0 + q) * 16, 32, lane); }
#pragma unroll
        for (int q = 0; q < 2; ++q) acc[q] = MFMA16(tf[q][0], b0, ((f32x4){0.f, 0.f, 0.f, 0.f}));
#pragma unroll
        for (int q = 0; q < 2; ++q) acc[q] = MFMA16(tf[q][1], b1, acc[q]);
#pragma unroll
        for (int q = 0; q < 2; ++q) *(u32x2*)(sP2 + ((vt * 16 + l15) * 72 + (tt0 + q) * 16 + quad * 4) * 2) = PACK4(acc[q]);
    }
    __syncthreads();
    {
        const int c = wave & 3, half = wave >> 2;
        const bf16x8 gp1a = ldfrag(sP1, 72, c * 16, 0, lane), gp1b = ldfrag(sP1, 72, c * 16, 32, lane);
        const bf16x8 gva = ldfrag(sV, 72, c * 16, 0, lane), gvb = ldfrag(sV, 72, c * 16, 32, lane);
        const bf16x8 gp2a = ldfrag(sP2, 72, c * 16, 0, lane), gp2b = ldfrag(sP2, 72, c * 16, 32, lane);
        bf16x8 gbd[2][2], gkd[2][2];
#pragma unroll
        for (int q = 0; q < 2; ++q) { const int kt = half * 2 + q;
            gbd[q][0] = ldfrag(sBd, 72, kt * 16, 0, lane); gbd[q][1] = ldfrag(sBd, 72, kt * 16, 32, lane);
            gkd[q][0] = ldfrag(sKd, 72, kt * 16, 0, lane); gkd[q][1] = ldfrag(sKd, 72, kt * 16, 32, lane); }
        const f32x4 zero4 = {0.f, 0.f, 0.f, 0.f};
#pragma unroll
        for (int q = 0; q < 2; ++q) { const int tt = half * 2 + q;
            const bf16x8 ab0 = ldfrag(sAb, 72, tt * 16, 0, lane), ab1 = ldfrag(sAb, 72, tt * 16, 32, lane), ak0 = ldfrag(sAk, 72, tt * 16, 0, lane), ak1 = ldfrag(sAk, 72, tt * 16, 32, lane);
            f32x4 aq = MFMA16(gp1a, ab0, zero4), a1 = MFMA16(ak0, gva, zero4), a2 = MFMA16(ab0, gp2a, zero4);
            aq = MFMA16(gp1b, ab1, aq); a1 = MFMA16(ak1, gvb, a1); a2 = MFMA16(ab1, gp2b, a2);
            const int t = tt * 16 + l15, k0 = c * 16 + quad * 4;
            const u32x2 rw = *(const u32x2*)(sRho + (t * 72 + k0) * 2);
            f32x4 ovq = {bf_lo(rw.x) - aq[0], bf_hi(rw.x) - aq[1], bf_lo(rw.y) - aq[2], bf_hi(rw.y) - aq[3]};
            *(u32x2*)(gQ + t * 64 + k0) = PACK4(ovq);
            f32x4 ovy = a1 - a2;
            *(u32x2*)(gY0 + ((tt * 4 + c) * 64 + lane) * 4) = PACK4(ovy); }
#pragma unroll
        for (int q = 0; q < 2; ++q) { const int kt = half * 2 + q;
            f32x4 af = MFMA16(gp1a, gbd[q][0], zero4), a1 = MFMA16(gkd[q][0], gva, zero4), a2 = MFMA16(gbd[q][0], gp2a, zero4);
            af = MFMA16(gp1b, gbd[q][1], af); a1 = MFMA16(gkd[q][1], gvb, a1); a2 = MFMA16(gbd[q][1], gp2b, a2);
            f32x4 ovf = {-af[0], -af[1], -af[2], -af[3]};
            *(u32x2*)(gF + (kt * 16 + l15) * 64 + c * 16 + quad * 4) = PACK4(ovf);
            f32x4 ovs = a1 - a2;
            *(u32x2*)(gS0 + ((kt * 4 + c) * 64 + lane) * 4) = PACK4(ovs); }
    }
    __syncthreads();
}

struct RwSet { u32x4 pq, pf; u32x2 py[4], ps[4]; float wc1; u32x4 cv, qv, gt; float bsc; };
__device__ __forceinline__ void rw_fetch(const Params& p, RwSet& s, int bh, int n, int b, int chn, int tid, int wave, int lane, int quad) {
    const bf16_t* P = (const bf16_t*)(p.ws + WS_P);
    const unsigned char* blk = rwp_ptr(p, bh * NCH + n);
    const int w4 = wave & 3;
    s.pq = *(const u32x4*)(blk + tid * 16); s.pf = *(const u32x4*)(blk + 8192 + tid * 16);
#pragma unroll
    for (int i = 0; i < 4; ++i) { s.py[i] = *(const u32x2*)(blk + 16384 + (((i * 4 + w4) * 64 + lane) * 8)); s.ps[i] = *(const u32x2*)(blk + 24576 + (((i * 4 + w4) * 64 + lane) * 8)); }
    s.wc1 = ((const float*)(blk + 32768))[tid & 63];
    const int tp = n * 64 + (tid >> 3) - 48, tpc = tp < 0 ? 0 : tp, tpp = tp < 1 ? 0 : tp - 1;
    const bf16_t* rowp = P + (size_t)rowof(b, tpc) * NP + chn;
    s.cv = *(const u32x4*)(rowp + C_V); s.gt = *(const u32x4*)(rowp + C_G); s.bsc = ((const float*)(blk + 33024))[tid >> 3];
    s.qv = *(const u32x4*)(P + (size_t)rowof(b, tpp) * NP + chn + C_V);
    if (tp < 1) s.qv = (u32x4){0u, 0u, 0u, 0u};
}
__device__ __forceinline__ void rw_chunk(const Params& p, RwSet& s, f32x4 (&S)[4], int bh, int n, int b, int chn, int tid, int wave, int lane, int l15, int quad,
                                         unsigned char* Ql, unsigned char* Fl, unsigned char* St, float* Yl, const float* Cst) {
    bf16_t* P = (bf16_t*)(p.ws + WS_P);
    const int pt = tid >> 3, pc8 = (tid & 7) * 8;
    __syncthreads();
    *(u32x4*)(Ql + ((tid >> 3) * 72 + (tid & 7) * 8) * 2) = s.pq; *(u32x4*)(Fl + ((tid >> 3) * 72 + (tid & 7) * 8) * 2) = s.pf;
    f32x4 y[4], sadd[4];
#pragma unroll
    for (int i = 0; i < 4; ++i) { y[i] = (f32x4){bf_lo(s.py[i].x), bf_hi(s.py[i].x), bf_lo(s.py[i].y), bf_hi(s.py[i].y)};
        sadd[i] = (f32x4){bf_lo(s.ps[i].x), bf_hi(s.ps[i].x), bf_lo(s.ps[i].y), bf_hi(s.ps[i].y)}; }
    float* WCl = Yl + 64 * 68 + 192;
    if (tid < 64) WCl[tid] = s.wc1;
    const u32x4 cv = s.cv, qv = s.qv, gt = s.gt; const float bsc = s.bsc;
    const int tp = n * 64 + pt - 48; const bool valid = tp >= 0;
    __syncthreads();
    if (n + 2 < NCH) rw_fetch(p, s, bh, n + 2, b, chn, tid, wave, lane, quad);
    if (wave < 4) {
#pragma unroll
        for (int kt = 0; kt < 4; ++kt) *(u32x2*)(St + (l15 * 72 + kt * 16 + quad * 4) * 2) = PACK4(S[kt]);
        asm volatile("s_waitcnt lgkmcnt(0)" ::: "memory");
        const bf16x8 sf0 = ldfrag(St, 72, 0, 0, lane), sf1 = ldfrag(St, 72, 0, 32, lane);
        bf16x8 fq[4][2], ff[4][2];
#pragma unroll
        for (int i = 0; i < 4; ++i) { ff[i][0] = ldfrag(Fl, 72, i * 16, 0, lane); ff[i][1] = ldfrag(Fl, 72, i * 16, 32, lane); }
#pragma unroll
        for (int i = 0; i < 4; ++i) { fq[i][0] = ldfrag(Ql, 72, i * 16, 0, lane); fq[i][1] = ldfrag(Ql, 72, i * 16, 32, lane); }
        f32x4 sn[4];
#pragma unroll
        for (int kt = 0; kt < 4; ++kt) sn[kt] = S[kt] * *(const f32x4*)(WCl + kt * 16 + quad * 4) + sadd[kt];
#pragma unroll
        for (int kt = 0; kt < 4; ++kt) sn[kt] = MFMA16(ff[kt][0], sf0, sn[kt]);
#pragma unroll
        for (int kt = 0; kt < 4; ++kt) S[kt] = MFMA16(ff[kt][1], sf1, sn[kt]);
#pragma unroll
        for (int ct = 0; ct < 4; ++ct) y[ct] = MFMA16(fq[ct][0], sf0, y[ct]);
#pragma unroll
        for (int ct = 0; ct < 4; ++ct) y[ct] = MFMA16(fq[ct][1], sf1, y[ct]);
#pragma unroll
        for (int ct = 0; ct < 4; ++ct)
#pragma unroll
            for (int j = 0; j < 4; ++j) Yl[(ct * 16 + quad * 4 + j) * 68 + wave * 16 + l15] = y[ct][j];
    }
    __syncthreads();
    {
        const f32x4 y0 = *(const f32x4*)(Yl + pt * 68 + pc8), y1 = *(const f32x4*)(Yl + pt * 68 + pc8 + 4);
        float yv[8] = {y0[0], y0[1], y0[2], y0[3], y1[0], y1[1], y1[2], y1[3]};
        float sm = 0.f;
#pragma unroll
        for (int e = 0; e < 8; ++e) sm += yv[e];
        sm = sum8(sm); const float mean = sm * (1.f / 64.f);
        float sq = 0.f;
#pragma unroll
        for (int e = 0; e < 8; ++e) { yv[e] -= mean; sq += yv[e] * yv[e]; }
        sq = sum8(sq); const float rstd = rsqrtf(sq * (1.f / 64.f) + 64e-5f);
        float ov[8], muv[8], gw[8], gb[8];
#pragma unroll
        for (int e = 0; e < 8; ++e) { muv[e] = Cst[pc8 + e]; gw[e] = Cst[64 + pc8 + e]; gb[e] = Cst[128 + pc8 + e]; }
#pragma unroll
        for (int e = 0; e < 4; ++e) {
            const float c0 = bf_lo(cv[e]), c1 = bf_hi(cv[e]);
            const float v0 = c0 + (bf_lo(qv[e]) - c0) * muv[2 * e], v1 = c1 + (bf_hi(qv[e]) - c1) * muv[2 * e + 1];
            ov[2 * e] = (yv[2 * e] * rstd * gw[2 * e] + gb[2 * e] + bsc * v0) * siluf_(bf_lo(gt[e]));
            ov[2 * e + 1] = (yv[2 * e + 1] * rstd * gw[2 * e + 1] + gb[2 * e + 1] + bsc * v1) * siluf_(bf_hi(gt[e])); }
        if (valid) { u32x4 w; w.x = cvt_pk_bf16(ov[0], ov[1]); w.y = cvt_pk_bf16(ov[2], ov[3]); w.z = cvt_pk_bf16(ov[4], ov[5]); w.w = cvt_pk_bf16(ov[6], ov[7]);
            *(u32x4*)(P + (size_t)rowof(b, tp) * NP + chn + C_G) = w; }
    }
}
__device__ __forceinline__ void rw_scan(const Params& p, int bh, unsigned char* lds) {
    const int b = bh >> 4, h = bh & 15, tid = opaque_tid(), lane = tid & 63, wave = tid >> 6, l15 = lane & 15, quad = lane >> 4;
    unsigned char* Ql = lds; unsigned char* Fl = lds + 9216;
    unsigned char* St = lds + 18432 + (wave & 3) * 2304;
    float* Yl = (float*)(lds + 27648);
    f32x4 S[4];
#pragma unroll
    for (int i = 0; i < 4; ++i) S[i] = (f32x4){0.f, 0.f, 0.f, 0.f};
    const int chn = h * 64 + (tid & 7) * 8;
    float* Cst = (float*)(lds + 45056);
    if (tid < 64) { Cst[tid] = p.mu[C_V + h * 64 + tid]; Cst[64 + tid] = p.gn_w[h * 64 + tid]; Cst[128 + tid] = p.gn_b[h * 64 + tid]; }
    RwSet s0, s1;
#pragma unroll
    for (int i = 0; i < 4; ++i) { s0.py[i] = (u32x2){0u, 0u}; s0.ps[i] = (u32x2){0u, 0u}; s1.py[i] = s0.py[i]; s1.ps[i] = s0.ps[i]; }
    rw_fetch(p, s0, bh, 0, b, chn, tid, wave, lane, quad);
    rw_fetch(p, s1, bh, 1, b, chn, tid, wave, lane, quad);
#pragma unroll 1
    for (int n = 0; n + 3 < NCH; n += 4) {
        rw_chunk(p, s0, S, bh, n, b, chn, tid, wave, lane, l15, quad, Ql, Fl, St, Yl, Cst);
        rw_chunk(p, s1, S, bh, n + 1, b, chn, tid, wave, lane, l15, quad, Ql, Fl, St, Yl, Cst);
        rw_chunk(p, s0, S, bh, n + 2, b, chn, tid, wave, lane, l15, quad, Ql, Fl, St, Yl, Cst);
        rw_chunk(p, s1, S, bh, n + 3, b, chn, tid, wave, lane, l15, quad, Ql, Fl, St, Yl, Cst);
    }
    static_assert(NCH % 4 == 1, "tail below handles exactly one chunk");
    rw_chunk(p, s0, S, bh, NCH - 1, b, chn, tid, wave, lane, l15, quad, Ql, Fl, St, Yl, Cst);
}
__global__ void __launch_bounds__(512, 2) hymba_fwd(Params p) {
    extern __shared__ __attribute__((aligned(16))) unsigned char lds[];
    cg::grid_group grid = cg::this_grid();
#define GSYNC() do { asm volatile("s_waitcnt vmcnt(0)" ::: "memory"); grid.sync(); \
        if (threadIdx.x < 64) { __builtin_amdgcn_fence(__ATOMIC_ACQUIRE, "agent"); asm volatile("s_waitcnt vmcnt(0)" ::: "memory"); } __syncthreads(); } while (0)
    const int G = gridDim.x, bid = blockIdx.x;
    volatile LAS unsigned* xbst = (volatile LAS unsigned*)((LAS unsigned char*)lds + (LDS_BYTES - 16));
    if (threadIdx.x == 0) { xbst[0] = 0u; xbst[1] = 0u; }
    __syncthreads();
    const XcdBarrier xbar = xcd_barrier_post((unsigned*)(p.ws + WS_BAR), xbst);
    bf16_t* P = (bf16_t*)(p.ws + WS_P);
    GSYNC();
    phase0(p, lds);
    xcd_barrier(xbar);
    {
        pg8::Gemm g{(const bf16_t*)(p.ws + WS_U), (const bf16_t*)(p.ws + WS_WINT), MP, NP, DM, DM};
        pg8::StaticOrder S; S.init(MP, NP, G, bid);
        pg8::EpiBf16 E{P, NP};
        pg8::gemm_phase<pg8::EpiBf16, pg8::StaticOrder, true, true>((PG8_LAS unsigned char*)lds, g, S, E);
    }
    xcd_barrier(xbar);
    {
        RwIn rin; int job = bid;
#pragma unroll
        for (int i = 0; i < 4; ++i) rin.mul[i] = *(const f32x4*)(p.mu + 3072 + (threadIdx.x & 7) * 16 + 4 * i);
        if (job < 64 * NCH) rw_load(p, job, rin, threadIdx.x);
        for (; job < 64 * NCH; job += G) rw_prep(p, job, lds, rin, job + G < 64 * NCH ? job + G : -1);
    }
    {
        DnIn din; int job = (bid + 192) % G;
        if (job < 32 * NCH) dn_load(p, job, din, threadIdx.x);
        for (; job < 32 * NCH; job += G) dn_prep(p, job, lds, din, job + G < 32 * NCH ? job + G : -1);
    }
    xcd_barrier(xbar);
    for (int job = bid; job < 64 + 32 * DN_PARTS; job += G) {
        if (job < 64) rw_scan(p, job, lds);
        else { const int q = job - 64, grp = q / (8 * DN_PARTS), r = q % (8 * DN_PARTS);
               dn_scan(p, grp * 8 + (r & 7), r >> 3, lds); }
        __syncthreads();
    }
    xcd_barrier(xbar);
    {
        const int tidp = opaque_tid(); DnPostIn pin, cur; int job = bid;
        if (job < 32 * NCH) dn_post_load(p, job, pin, tidp);
        for (; job < 32 * NCH; job += G) { cur = pin; if (job + G < 32 * NCH) dn_post_load(p, job + G, pin, tidp); dn_post(p, job, cur, tidp); }
    }
    xcd_barrier(xbar);
    if (G == 256) {
        pg8::Gemm g{P + C_G, (const bf16_t*)(p.ws + WS_WOUTT), NREAL, DM, DM, NP};
        pg8::PanelOrder S; S.c = bid;
        pg8::EpiResidNorm E{p.x, p.out, DM, (float*)(p.ws + WS_ROWSS), (unsigned*)(p.ws + WS_CNT), p.fnorm_w};
        pg8::gemm_phase<pg8::EpiResidNorm, pg8::PanelOrder, false, true>((PG8_LAS unsigned char*)lds, g, S, E);
    } else {
        {
            pg8::Gemm g{P + C_G, (const bf16_t*)(p.ws + WS_WOUTT), NREAL, DM, DM, NP};
            pg8::StaticOrder S; S.init(NREAL, DM, G, bid);
            pg8::EpiResid E{p.x, p.out, DM, (float*)(p.ws + WS_ROWSS)};
            pg8::gemm_phase<pg8::EpiResid, pg8::StaticOrder>((PG8_LAS unsigned char*)lds, g, S, E);
        }
        xcd_barrier(xbar);
        phase_final(p);
    }
}

extern "C" void kernel_launch(void* const* d_in, const int* in_sizes, int n_in, void* d_out, int out_size, void* d_ws, size_t ws_size, hipStream_t stream) {
    static int grid_blocks = 0;
    if (grid_blocks == 0) {
        if (n_in != 20 || ws_size < WS_END) { fprintf(stderr, "kernel_launch: unexpected n_in %d / ws_size %zu (need %zu)\n", n_in, ws_size, (size_t)WS_END); grid_blocks = -1; return; }
        int dev = 0, cus = 0, per_cu = 0;
        (void)hipGetDevice(&dev);
        (void)hipDeviceGetAttribute(&cus, hipDeviceAttributeMultiprocessorCount, dev);
        if (hipFuncSetAttribute((const void*)hymba_fwd, hipFuncAttributeMaxDynamicSharedMemorySize, LDS_BYTES) != hipSuccess) { fprintf(stderr, "kernel_launch: hipFuncSetAttribute failed\n"); grid_blocks = -1; return; }
        (void)hipOccupancyMaxActiveBlocksPerMultiprocessor(&per_cu, (const void*)hymba_fwd, 512, LDS_BYTES);
        (void)hipGetLastError();
        if (per_cu < 1) per_cu = 1;
        grid_blocks = cus * per_cu;
        if (grid_blocks > 256) grid_blocks = 256;
    }
    if (grid_blocks < 0) return;
    Params p{};
    p.x = (const float*)d_in[0]; p.meta = (const float*)d_in[1]; p.norm_w = (const float*)d_in[2]; p.w_in = (const float*)d_in[3]; p.mu = (const float*)d_in[4];
    p.w0 = (const float*)d_in[5]; p.w2 = (const float*)d_in[6]; p.a0 = (const float*)d_in[7]; p.a2 = (const float*)d_in[8]; p.k_k = (const float*)d_in[9];
    p.k_a = (const float*)d_in[10]; p.r_k = (const float*)d_in[11]; p.gn_w = (const float*)d_in[12]; p.gn_b = (const float*)d_in[13]; p.conv_w = (const float*)d_in[14];
    p.A_log = (const float*)d_in[15]; p.dt_bias = (const float*)d_in[16]; p.dn_norm_w = (const float*)d_in[17]; p.w_out = (const float*)d_in[18]; p.fnorm_w = (const float*)d_in[19];
    p.out = (float*)d_out; p.ws = (unsigned char*)d_ws;
    (void)hipMemsetAsync((unsigned char*)d_ws + WS_BAR, 0, 16384 + 128 * 256, stream);
    void* args[] = {&p};
    hipError_t e = hipLaunchCooperativeKernel((const void*)hymba_fwd, dim3(grid_blocks), dim3(512), args, LDS_BYTES, stream);
    if (e != hipSuccess) fprintf(stderr, "cooperative launch failed: %s (grid %d)\n", hipGetErrorString(e), grid_blocks);
}
```

```cpp
#include <hip/hip_runtime.h>
#include <hip/hip_cooperative_groups.h>
#include <cstdio>
#include <cstdint>
namespace cg = cooperative_groups;
#ifndef TESTMODE
#define TESTMODE 0
#endif

#define LAS __attribute__((address_space(3)))
typedef unsigned short bf16_t;
typedef short bf16x8 __attribute__((ext_vector_type(8)));
typedef float f32x4 __attribute__((ext_vector_type(4)));
typedef unsigned u32x2 __attribute__((ext_vector_type(2)));
typedef unsigned u32x4 __attribute__((ext_vector_type(4)));

constexpr int NB = 4, SEQ = 4096, NMETA = 16, LT = SEQ + NMETA, DM = 2048;
constexpr int NREAL = NB * SEQ;
constexpr int TOK = NB * LT;
constexpr int MP = 16640;
constexpr int NP = 8448;
constexpr int C_R = 0, C_K = 1024, C_V = 2048, C_G = 3072, C_Z = 4096, C_DQ = 5120, C_DK = 6144, C_DV = 7168;
constexpr int C_LW = 8192, C_LA = 8256, C_DB = 8320, C_DA = 8328;
constexpr int NCH = 65;
constexpr int LDS_BYTES = 147456;

constexpr size_t MiB = 1u << 20;
constexpr size_t WS_ROWSS = 500 * MiB;
constexpr size_t WS_BAR = 512 * 1024;
constexpr size_t WS_CNT = 512 * 1024 + 16384;
constexpr size_t WS_DNG = 256 * 1024;
constexpr size_t WS_WOUTT = 1 * MiB;
constexpr size_t WS_W2T = 9 * MiB;
constexpr size_t WS_A2T = 9 * MiB + 256 * 1024;
constexpr size_t WS_P = 10 * MiB;
constexpr size_t WS_U = 279 * MiB;
constexpr size_t WS_WINT = 344 * MiB;
constexpr size_t WS_DNP = 279 * MiB;
constexpr size_t WS_RWP = 426 * MiB;
constexpr size_t DNP_BLK = 73728;
constexpr size_t WS_END = 502 * MiB;

struct Params {
    const float* x; const float* meta; const float* norm_w; const float* w_in; const float* mu; const float* w0; const float* w2;
    const float* a0; const float* a2; const float* k_k; const float* k_a; const float* r_k; const float* gn_w; const float* gn_b;
    const float* conv_w; const float* A_log; const float* dt_bias; const float* dn_norm_w; const float* w_out; const float* fnorm_w;
    float* out; unsigned char* ws;
};

typedef float f32x2_t __attribute__((ext_vector_type(2)));
typedef __bf16 bf16x2_t __attribute__((ext_vector_type(2)));
__device__ __forceinline__ unsigned cvt_pk_bf16(float lo, float hi) { const f32x2_t v = {lo, hi}; return __builtin_bit_cast(unsigned, __builtin_convertvector(v, bf16x2_t)); }
__device__ __forceinline__ unsigned cvt_pk_bf16_asm(float lo, float hi) { unsigned r; asm volatile("v_cvt_pk_bf16_f32 %0, %1, %2" : "=v"(r) : "v"(lo), "v"(hi)); return r; }
__device__ __forceinline__ int opaque_tid() { int t = threadIdx.x; asm volatile("" : "+v"(t)); return t; }
__device__ __forceinline__ float bf_lo(unsigned w) { return __uint_as_float(w << 16); }
__device__ __forceinline__ float bf_hi(unsigned w) { return __uint_as_float(w & 0xffff0000u); }
__device__ __forceinline__ float bf2f(bf16_t b) { return __uint_as_float(((unsigned)b) << 16); }
__device__ __forceinline__ int rowof(int b, int tp) { return tp < NMETA ? NREAL + b * NMETA + tp : b * SEQ + tp - NMETA; }
__device__ __forceinline__ float sigmoidf_(float x) { return __builtin_amdgcn_rcpf(1.f + __expf(-x)); }
__device__ __forceinline__ float siluf_(float x) { return x * __builtin_amdgcn_rcpf(1.f + __expf(-x)); }
__device__ __forceinline__ float softplusf_(float x) { return fmaxf(x, 0.f) + log1pf(__expf(-fabsf(x))); }
__device__ __forceinline__ float dppf(float x, const int ctrl_sel) {
    int v = __float_as_int(x), r;
    if (ctrl_sel == 0) r = __builtin_amdgcn_update_dpp(0, v, 0xB1, 0xF, 0xF, false);
    else if (ctrl_sel == 1) r = __builtin_amdgcn_update_dpp(0, v, 0x4E, 0xF, 0xF, false);
    else if (ctrl_sel == 2) r = __builtin_amdgcn_update_dpp(0, v, 0x141, 0xF, 0xF, false);
    else r = __builtin_amdgcn_update_dpp(0, v, 0x140, 0xF, 0xF, false);
    return __int_as_float(r);
}
__device__ __forceinline__ float sum8(float x) { x += dppf(x, 0); x += dppf(x, 1); x += dppf(x, 2); return x; }
__device__ __forceinline__ float sum16(float x) { x = sum8(x); x += dppf(x, 3); return x; }
__device__ __forceinline__ bf16x8 ldfrag(const unsigned char* base, int ld_elems, int r0, int k0, int lane) {
    const int lo = ((lane & 15) * ld_elems + (lane >> 4) * 8) * 2;
    return *(const bf16x8*)(base + lo + (r0 * ld_elems + k0) * 2);
}
#define MFMA16(a, b, c) __builtin_amdgcn_mfma_f32_16x16x32_bf16((a), (b), (c), 0, 0, 0)

namespace pg8 {
#define PG8_LAS __attribute__((address_space(3)))
constexpr int BM = 256, BK = 64, HALF = 128, HTB = HALF * BK * 2, STAGE_BYTES = 8 * HTB, NXCD = 8, WGM = 8;
__host__ __device__ __forceinline__ int lds_byte(int r, int c) { const int st = (r >> 4) * 2 + (c >> 5), rr = r & 15, cc = c & 31, ob = rr * 64 + cc * 2; return st * 1024 + (ob ^ (((ob >> 9) & 1) << 5)); }
__host__ __device__ __forceinline__ void stage_rc(int b, int& R, int& C) { const int st = b / 1024, sb = b % 1024, swz = sb ^ (((sb >> 9) & 1) << 5); R = (st >> 1) * 16 + swz / 64; C = (st & 1) * 32 + (swz % 64) / 2; }
__host__ __device__ __forceinline__ int perm32(int rho) { const int n = rho >> 4, i = rho & 15; return 8 * (i >> 2) + 4 * n + (i & 3); }
struct Unit { int pm, pn; };
struct Gemm { const bf16_t* A; const bf16_t* Bt; int M, N, K, lda; };
struct StaticOrder {
    int nM, nN, nwg, G, c;
    __host__ __device__ void init(int M, int N, int G_, int c_) { nM = M / BM; nN = N / BM; nwg = nM * nN; G = G_; c = c_; }
    __host__ __device__ bool next(int i, Unit& u) const {
        const long L = (long)i * G + c; if (L >= nwg) return false;
        int wgid = (int)L; { const int q = nwg / NXCD, r = nwg % NXCD, xcd = wgid % NXCD, off = wgid / NXCD; wgid = (xcd < r ? xcd * (q + 1) : r * (q + 1) + (xcd - r) * q) + off; }
        const int nig = WGM * nN, gid = wgid / nig, fm = gid * WGM, gsz = (nM - fm) < WGM ? (nM - fm) : WGM;
        u.pm = fm + ((wgid % nig) % gsz); u.pn = (wgid % nig) / gsz; return true;
    }
    __device__ __forceinline__ void a_ready(const Unit&) const {}
    __device__ __forceinline__ void done(const Unit&) const {}
};
struct EpiBf16 {
    static constexpr bool PERM = true;
    bf16_t* O; int ldc;
    __device__ __forceinline__ void operator()(const f32x4 (&acc)[2][2][4][2], const Unit& u, int wr, int wc, int fr, int fq) const {
        const int row0 = u.pm * BM + wr * 64 + fr; const int col0 = u.pn * BM + wc * 32 + 8 * fq;
#pragma unroll
        for (int ai = 0; ai < 2; ++ai)
#pragma unroll
            for (int m = 0; m < 4; ++m) { bf16_t* rowp = O + (size_t)(row0 + ai * HALF + m * 16) * ldc + col0;
#pragma unroll
                for (int bj = 0; bj < 2; ++bj) { const f32x4 v0 = acc[ai][bj][m][0], v1 = acc[ai][bj][m][1];
                    u32x4 w; w.x = cvt_pk_bf16_asm(v0[0], v0[1]); w.y = cvt_pk_bf16_asm(v0[2], v0[3]); w.z = cvt_pk_bf16_asm(v1[0], v1[1]); w.w = cvt_pk_bf16_asm(v1[2], v1[3]);
                    *(u32x4*)(rowp + bj * HALF) = w; } }
    }
};
struct EpiResid {
    static constexpr bool PERM = false;
    const float* base; float* out; int ldc; float* rowss;
    __device__ __forceinline__ void operator()(const f32x4 (&acc)[2][2][4][2], const Unit& u, int wr, int wc, int fr, int fq) const {
        const int row0 = u.pm * BM + wr * 64 + fr, col0 = u.pn * BM + wc * 32 + 4 * fq;
#pragma unroll
        for (int ai = 0; ai < 2; ++ai)
#pragma unroll
            for (int m = 0; m < 4; ++m) { const int row = row0 + ai * HALF + m * 16; const size_t off = (size_t)row * ldc + col0; float ss = 0.f;
#pragma unroll
                for (int bj = 0; bj < 2; ++bj)
#pragma unroll
                    for (int n = 0; n < 2; ++n) { const f32x4 bs = *(const f32x4*)(base + off + bj * HALF + n * 16); const f32x4 v = bs + acc[ai][bj][m][n];
                        *(f32x4*)(out + off + bj * HALF + n * 16) = v; ss += v[0] * v[0] + v[1] * v[1] + v[2] * v[2] + v[3] * v[3]; }
                ss += __shfl_xor(ss, 16); ss += __shfl_xor(ss, 32);
                if (fq == 0) rowss[(size_t)row * 32 + u.pn * 4 + wc] = ss; }
    }
};

struct EpiResidNorm {
    static constexpr bool PERM = false;
    const float* base; float* out; int ldc; float* rowss; unsigned* cnt; const float* fw;
    __device__ __forceinline__ void operator()(f32x4 (&acc)[2][2][4][2], const Unit& u, int wr, int wc, int fr, int fq) const {
        const int row0 = u.pm * BM + wr * 64 + fr, col0 = u.pn * BM + wc * 32 + 4 * fq;
#pragma unroll
        for (int ai = 0; ai < 2; ++ai)
#pragma unroll
            for (int m = 0; m < 4; ++m) { const int row = row0 + ai * HALF + m * 16; const size_t off = (size_t)row * ldc + col0; float ss = 0.f;
#pragma unroll
                for (int bj = 0; bj < 2; ++bj)
#pragma unroll
                    for (int n = 0; n < 2; ++n) { const f32x4 bs = *(const f32x4*)(base + off + bj * HALF + n * 16); const f32x4 v = bs + acc[ai][bj][m][n];
                        acc[ai][bj][m][n] = v; ss += v[0] * v[0] + v[1] * v[1] + v[2] * v[2] + v[3] * v[3]; }
                ss += __shfl_xor(ss, 16); ss += __shfl_xor(ss, 32);
                if (fq == 0) __hip_atomic_store(rowss + (size_t)row * 32 + u.pn * 4 + wc, ss, __ATOMIC_RELAXED, __HIP_MEMORY_SCOPE_AGENT); }
        asm volatile("s_waitcnt vmcnt(0)" ::: "memory");
        unsigned* c = cnt + (u.pm * 2 + wr) * 64;
        if ((threadIdx.x & 63) == 0) (void)__hip_atomic_fetch_add(c, 1u, __ATOMIC_RELAXED, __HIP_MEMORY_SCOPE_AGENT);
        {   unsigned spins = 0;
            while ((unsigned)__builtin_amdgcn_readfirstlane((int)__hip_atomic_load(c, __ATOMIC_RELAXED, __HIP_MEMORY_SCOPE_AGENT)) < 32u) { __builtin_amdgcn_s_sleep(2); if (++spins > (1u << 22)) break; } }
        __builtin_amdgcn_fence(__ATOMIC_ACQUIRE, "agent");
        asm volatile("s_waitcnt vmcnt(0)" ::: "memory");
        f32x4 fwv[2][2];
#pragma unroll
        for (int bj = 0; bj < 2; ++bj)
#pragma unroll
            for (int n = 0; n < 2; ++n) fwv[bj][n] = *(const f32x4*)(fw + col0 + bj * HALF + n * 16);
#pragma unroll
        for (int ai = 0; ai < 2; ++ai)
#pragma unroll
            for (int m = 0; m < 4; ++m) { const int row = row0 + ai * HALF + m * 16; const size_t off = (size_t)row * ldc + col0;
                const f32x4 p0 = *(const f32x4*)(rowss + (size_t)row * 32 + fq * 8), p1 = *(const f32x4*)(rowss + (size_t)row * 32 + fq * 8 + 4);
                float t = ((p0[0] + p0[1]) + (p0[2] + p0[3])) + ((p1[0] + p1[1]) + (p1[2] + p1[3]));
                t += __shfl_xor(t, 16); t += __shfl_xor(t, 32);
                const float sc = rsqrtf(t * (1.f / 2048.f) + 1e-6f);
#pragma unroll
                for (int bj = 0; bj < 2; ++bj)
#pragma unroll
                    for (int n = 0; n < 2; ++n) { const f32x4 v = acc[ai][bj][m][n], w = fwv[bj][n];
                        *(f32x4*)(out + off + bj * HALF + n * 16) = (f32x4){v[0] * sc * w[0], v[1] * sc * w[1], v[2] * sc * w[2], v[3] * sc * w[3]}; } }
    }
};
struct PanelOrder {
    int c;
    __device__ bool next(int i, Unit& u) const { if (i >= 2) return false; const int x = c & 7, y = c >> 3; u.pm = 32 * i + 4 * x + (y >> 3); u.pn = y & 7; return true; }
    __device__ __forceinline__ void a_ready(const Unit&) const {}
    __device__ __forceinline__ void done(const Unit&) const {}
};

struct MainOrder2048 {
    int G, c;
    __device__ bool next(int i, Unit& u) const {
        const int L = i * G + c; if (L >= 2048) return false;
        const int w = (L & 7) * 256 + (L >> 3);
        if (w < 200) { const int cc = w >> 3; u.pm = w & 7; u.pn = cc < 12 ? cc : cc + 8; }
        else if (w < 431) { const int x = w - 200;
            if (x < 96) { u.pn = x >> 3; u.pm = 8 + (x & 7); }
            else if (x < 99) { u.pn = 12; u.pm = 13 + (x - 96); }
            else if (x < 127) { const int y = x - 99; u.pn = 13 + (y >> 2); u.pm = 12 + (y & 3); }
            else { const int y = x - 127; u.pn = 20 + (y >> 3); u.pm = 8 + (y & 7); } }
        else if (w < 2015) { const int x = w - 431, g = 2 + x / 264, y = x % 264; u.pn = y >> 3; u.pm = g * 8 + (y & 7); }
        else { u.pm = 64; u.pn = w - 2015; }
        return true;
    }
    __device__ __forceinline__ void a_ready(const Unit&) const {}
    __device__ __forceinline__ void done(const Unit&) const {}
};
struct LeftOrder97 {
    int c;
    __device__ bool next(int i, Unit& u) const {
        if (i > 0 || c >= 97) return false;
        if (c < 96) { u.pm = c >> 3; u.pn = 12 + (c & 7); } else { u.pm = 12; u.pn = 12; }
        return true;
    }
    __device__ __forceinline__ void a_ready(const Unit&) const {}
    __device__ __forceinline__ void done(const Unit&) const {}
};

template <class Epi, class Sched, bool ALIGN_EPI = false, bool SP2 = false>
__device__ __forceinline__ void gemm_phase(PG8_LAS unsigned char* lds, const Gemm g, const Sched& S, const Epi& E) {
    const int tid = opaque_tid(), wid = __builtin_amdgcn_readfirstlane(tid >> 6), lane = tid & 63, wr = wid >> 2, wc = wid & 3, fr = lane & 15, fq = lane >> 4;
    const int K = g.K, nt = K / BK, lda = g.lda;
    unsigned voffA[2], voffB[2];
#pragma unroll
    for (int i = 0; i < 2; ++i) { int R, C; stage_rc(tid * 16 + i * 8192, R, C); const int Rb = Epi::PERM ? ((R & ~31) + perm32(R & 31)) : R;
        voffA[i] = (unsigned)(R * lda + C) * 2u; voffB[i] = (unsigned)(Rb * K + C) * 2u; }
    const size_t kstep = (size_t)(BK * 2);
    const size_t hstepA = (size_t)HALF * lda * 2, hstepB = (size_t)HALF * K * 2;
    const size_t tstepA = 2 * hstepA, tstepB = 2 * hstepB;
    const unsigned ldsw = (unsigned)wid * 1024u;
    const int aoff = lds_byte(wr * 64 + fr, fq * 8), boff = lds_byte(wc * 32 + fr, fq * 8);
#define PG8_SA(b, h) (((b) * 2 + (h)) * HTB)
#define PG8_SB(b, h) ((4 + (b) * 2 + (h)) * HTB)
#define PG8_STAGE(bufoff, gbase, voff) do { _Pragma("unroll") for (int _i = 0; _i < 2; ++_i) \
        __builtin_amdgcn_global_load_lds((const unsigned*)((const char*)(gbase) + (voff)[_i]), (PG8_LAS unsigned*)(lds + (bufoff) + ldsw + _i * 8192), 16, 0, 0); } while (0)
#define PG8_LDA(dst, b, h) do { _Pragma("unroll") for (int m = 0; m < 4; ++m) _Pragma("unroll") for (int k = 0; k < 2; ++k) dst[m][k] = *(const PG8_LAS bf16x8*)(lds + PG8_SA(b, h) + aoff + m * 2048 + k * 1024); } while (0)
#define PG8_LDB(dst, b, h) do { _Pragma("unroll") for (int n = 0; n < 2; ++n) _Pragma("unroll") for (int k = 0; k < 2; ++k) dst[n][k] = *(const PG8_LAS bf16x8*)(lds + PG8_SB(b, h) + boff + n * 2048 + k * 1024); } while (0)
#define PG8_MMA(ai, bj, At, Bt) do { __builtin_amdgcn_s_setprio(1); _Pragma("unroll") for (int m = 0; m < 4; ++m) _Pragma("unroll") for (int n = 0; n < 2; ++n) _Pragma("unroll") for (int k = 0; k < 2; ++k) \
        acc[ai][bj][m][n] = __builtin_amdgcn_mfma_f32_16x16x32_bf16(Bt[n][k], At[m][k], acc[ai][bj][m][n], 0, 0, 0); __builtin_amdgcn_s_setprio(0); } while (0)
#define PG8_WAIT_V(n) asm volatile("s_waitcnt vmcnt(" #n ")" ::: "memory")
#define PG8_WAIT_L(n) asm volatile("s_waitcnt lgkmcnt(" #n ")" ::: "memory")
#define PG8_BAR __builtin_amdgcn_s_barrier()
#define PG8_SCHED __builtin_amdgcn_sched_barrier(0)
    Unit cur, nxt; int ui = 0;
    if (!S.next(0, cur)) return;
    f32x4 acc[2][2][4][2];
#pragma unroll
    for (int a = 0; a < 2; ++a)
#pragma unroll
        for (int b = 0; b < 2; ++b)
#pragma unroll
            for (int m = 0; m < 4; ++m)
#pragma unroll
                for (int n = 0; n < 2; ++n) acc[a][b][m][n] = (f32x4){0.f, 0.f, 0.f, 0.f};
    bf16x8 At[4][2], B0[2][2], B1[2][2];
    const char* cA = (const char*)g.A + (size_t)cur.pm * tstepA; const char* cB = (const char*)g.Bt + (size_t)cur.pn * tstepB;
    S.a_ready(cur);
    if constexpr (SP2) {
        PG8_STAGE(PG8_SB(0, 0), cB, voffB); PG8_STAGE(PG8_SB(0, 1), cB + hstepB, voffB); PG8_STAGE(PG8_SA(0, 0), cA, voffA); PG8_STAGE(PG8_SA(0, 1), cA + hstepA, voffA);
        if (wr == 1) PG8_BAR;
        PG8_WAIT_V(2); PG8_BAR;
        PG8_STAGE(PG8_SB(1, 0), cB + kstep, voffB); PG8_STAGE(PG8_SA(1, 0), cA + kstep, voffA); PG8_STAGE(PG8_SB(1, 1), cB + hstepB + kstep, voffB);
        PG8_WAIT_V(6); PG8_BAR;
    } else {
    PG8_STAGE(PG8_SB(0, 0), cB, voffB); PG8_STAGE(PG8_SA(0, 0), cA, voffA); PG8_STAGE(PG8_SB(0, 1), cB + hstepB, voffB); PG8_STAGE(PG8_SA(0, 1), cA + hstepA, voffA);
    if (wr == 1) PG8_BAR;
    PG8_WAIT_V(4); PG8_BAR;
    PG8_STAGE(PG8_SB(1, 0), cB + kstep, voffB); PG8_STAGE(PG8_SA(1, 0), cA + kstep, voffA); PG8_STAGE(PG8_SB(1, 1), cB + hstepB + kstep, voffB);
    PG8_WAIT_V(6); PG8_BAR;
    }
    for (;;) {
        const bool has_next = S.next(ui + 1, nxt);
        const char* nA = has_next ? (const char*)g.A + (size_t)nxt.pm * tstepA : cA; const char* nB = has_next ? (const char*)g.Bt + (size_t)nxt.pn * tstepB : cB;
        for (int t = 0; t < nt; t += 2) {
            const bool last = (t == nt - 2);
            const char* a1 = cA + (size_t)(t + 1) * kstep;
            const char* a2 = last ? nA : cA + (size_t)(t + 2) * kstep; const char* b2 = last ? nB : cB + (size_t)(t + 2) * kstep;
            const char* a3 = a2 + kstep; const char* b3 = b2 + kstep;
            if (last && has_next) S.a_ready(nxt);
            if constexpr (SP2) {
            PG8_LDB(B0, 0, 0); PG8_LDB(B1, 0, 1); PG8_SCHED; PG8_LDA(At, 0, 0); PG8_STAGE(PG8_SA(1, 1), a1 + hstepA, voffA);
            PG8_WAIT_V(8); PG8_WAIT_L(0); PG8_BAR; PG8_MMA(0, 0, At, B0); PG8_MMA(0, 1, At, B1); PG8_BAR; PG8_SCHED;
            PG8_LDA(At, 0, 1); PG8_STAGE(PG8_SB(0, 0), b2, voffB); PG8_STAGE(PG8_SB(0, 1), b2 + hstepB, voffB); PG8_STAGE(PG8_SA(0, 0), a2, voffA);
            PG8_WAIT_V(8); PG8_WAIT_L(0); PG8_BAR; PG8_MMA(1, 0, At, B0); PG8_MMA(1, 1, At, B1); PG8_BAR; PG8_SCHED;
            PG8_LDB(B0, 1, 0); PG8_LDB(B1, 1, 1); PG8_SCHED; PG8_LDA(At, 1, 0); PG8_STAGE(PG8_SA(0, 1), a2 + hstepA, voffA);
            PG8_WAIT_V(8); PG8_WAIT_L(0); PG8_BAR; PG8_MMA(0, 0, At, B0); PG8_MMA(0, 1, At, B1); PG8_BAR; PG8_SCHED;
            PG8_LDA(At, 1, 1); PG8_STAGE(PG8_SB(1, 0), b3, voffB); PG8_STAGE(PG8_SB(1, 1), b3 + hstepB, voffB); PG8_STAGE(PG8_SA(1, 0), a3, voffA);
            PG8_WAIT_V(8); PG8_WAIT_L(0); PG8_BAR; PG8_MMA(1, 0, At, B0); PG8_MMA(1, 1, At, B1); PG8_BAR; PG8_SCHED;
            } else {
            PG8_LDB(B0, 0, 0); PG8_SCHED; PG8_LDA(At, 0, 0); PG8_STAGE(PG8_SA(1, 1), a1 + hstepA, voffA);
            PG8_WAIT_L(8); PG8_BAR; PG8_WAIT_L(0); PG8_MMA(0, 0, At, B0); PG8_BAR; PG8_SCHED;
            PG8_LDB(B1, 0, 1); PG8_STAGE(PG8_SB(0, 0), b2, voffB);
            PG8_BAR; PG8_WAIT_L(0); PG8_MMA(0, 1, At, B1); PG8_BAR;
            PG8_LDA(At, 0, 1); PG8_STAGE(PG8_SA(0, 0), a2, voffA);
            PG8_BAR; PG8_WAIT_L(0); PG8_MMA(1, 0, At, B0); PG8_BAR; PG8_SCHED;
            PG8_STAGE(PG8_SB(0, 1), b2 + hstepB, voffB);
            PG8_WAIT_V(6); PG8_BAR; PG8_MMA(1, 1, At, B1); PG8_BAR;
            PG8_LDB(B0, 1, 0); PG8_SCHED; PG8_LDA(At, 1, 0); PG8_STAGE(PG8_SA(0, 1), a2 + hstepA, voffA);
            PG8_WAIT_L(8); PG8_BAR; PG8_WAIT_L(0); PG8_MMA(0, 0, At, B0); PG8_BAR; PG8_SCHED;
            PG8_LDB(B1, 1, 1); PG8_STAGE(PG8_SB(1, 0), b3, voffB);
            PG8_BAR; PG8_WAIT_L(0); PG8_MMA(0, 1, At, B1); PG8_BAR;
            PG8_LDA(At, 1, 1); PG8_STAGE(PG8_SA(1, 0), a3, voffA);
            PG8_BAR; PG8_WAIT_L(0); PG8_MMA(1, 0, At, B0); PG8_BAR; PG8_SCHED;
            PG8_STAGE(PG8_SB(1, 1), b3 + hstepB, voffB);
            PG8_WAIT_V(6); PG8_BAR; PG8_MMA(1, 1, At, B1); PG8_BAR;
            }
        }
        if constexpr (ALIGN_EPI) { if (wr == 0) PG8_BAR; }
        E(acc, cur, wr, wc, fr, fq); S.done(cur);
        if (!has_next) break;
#pragma unroll
        for (int a = 0; a < 2; ++a)
#pragma unroll
            for (int b = 0; b < 2; ++b)
#pragma unroll
                for (int m = 0; m < 4; ++m)
#pragma unroll
                    for (int n = 0; n < 2; ++n) acc[a][b][m][n] = (f32x4){0.f, 0.f, 0.f, 0.f};
        cur = nxt; cA = nA; cB = nB; ++ui;
        if constexpr (ALIGN_EPI) { if (wr == 1) PG8_BAR; }
    }
    PG8_WAIT_V(0);
    if constexpr (!ALIGN_EPI) { if (wr == 0) PG8_BAR; }
    PG8_BAR;
#undef PG8_SA
#undef PG8_SB
#undef PG8_STAGE
#undef PG8_LDA
#undef PG8_LDB
#undef PG8_MMA
#undef PG8_WAIT_V
#undef PG8_WAIT_L
#undef PG8_BAR
#undef PG8_SCHED
}
}

__device__ __forceinline__ int refcol_win(int j) {
    if (j < 3072) return j;
    if (j < 4096) return 3200 + (j - 3072);
    if (j < 5120) return 7312 + (j - 4096);
    if (j < 8192) return 4224 + (j - 5120);
    if (j < 8320) return 3072 + (j - 8192);
    if (j < 8336) return 7296 + (j - 8320);
    return -1;
}
struct TJob { const float* src; bf16_t* dst; int src_ld, dst_ld, j0, k0, K; bool winmap; };
__device__ __forceinline__ TJob p0_decode(const Params& p, int job) {
    constexpr int J_WIN = (NP / 64) * 16, J_WOUT = (DM / 64) * 16, J_L = 16;
    TJob t;
    if (job < J_WIN) { t.src = p.w_in; t.src_ld = 8336; t.dst = (bf16_t*)(p.ws + WS_WINT); t.dst_ld = DM; t.j0 = (job >> 4) * 64; t.k0 = (job & 15) * 128; t.K = DM; t.winmap = true; }
    else if (job < J_WIN + J_WOUT) { const int q = job - J_WIN; t.src = p.w_out; t.src_ld = DM; t.dst = (bf16_t*)(p.ws + WS_WOUTT); t.dst_ld = DM; t.j0 = (q >> 4) * 64; t.k0 = (q & 15) * 128; t.K = DM; t.winmap = false; }
    else if (job < J_WIN + J_WOUT + J_L) { const int q = job - J_WIN - J_WOUT; t.src = p.w2; t.src_ld = 1024; t.dst = (bf16_t*)(p.ws + WS_W2T); t.dst_ld = 64; t.j0 = q * 64; t.k0 = 0; t.K = 64; t.winmap = false; }
    else { const int q = job - J_WIN - J_WOUT - J_L; t.src = p.a2; t.src_ld = 1024; t.dst = (bf16_t*)(p.ws + WS_A2T); t.dst_ld = 64; t.j0 = q * 64; t.k0 = 0; t.K = 64; t.winmap = false; }
    return t;
}
__device__ __forceinline__ void p0_load(const TJob& t, int tid, float (&v)[16]) {
    const int jj = tid & 63, j = t.j0 + jj; const int rc = t.winmap ? refcol_win(j) : j;
#pragma unroll
    for (int i = 0; i < 16; ++i) { const int k = t.k0 + i * 8 + (tid >> 6); v[i] = (rc >= 0 && k < t.K) ? t.src[(size_t)k * t.src_ld + rc] : 0.f; }
}
__device__ __forceinline__ void phase0(const Params& p, unsigned char* lds) {
    float* tile = (float*)lds;
    const int tid = opaque_tid(), G = gridDim.x, bid = blockIdx.x;
    constexpr int NJ = (NP / 64) * 16 + (DM / 64) * 16 + 32;
    {
        float v[16]; int job = bid;
        TJob t = p0_decode(p, job < NJ ? job : 0);
        if (job < NJ) p0_load(t, tid, v);
        while (job < NJ) {
            { const int jj = tid & 63;
#pragma unroll
              for (int i = 0; i < 16; ++i) tile[(i * 8 + (tid >> 6)) * 65 + jj] = v[i]; }
            __syncthreads();
            const int nxt = job + G; const TJob tn = p0_decode(p, nxt < NJ ? nxt : 0);
            if (nxt < NJ) p0_load(tn, tid, v);
            { const int jj = tid >> 3, kg = tid & 7;
#pragma unroll
              for (int half = 0; half < 2; ++half) { const int kb = half * 64 + kg * 8;
                  if (t.k0 + kb < t.K) { float x[8];
#pragma unroll
                      for (int i = 0; i < 8; ++i) x[i] = tile[(kb + i) * 65 + jj];
                      u32x4 w; w.x = cvt_pk_bf16(x[0], x[1]); w.y = cvt_pk_bf16(x[2], x[3]); w.z = cvt_pk_bf16(x[4], x[5]); w.w = cvt_pk_bf16(x[6], x[7]);
                      *(u32x4*)(t.dst + (size_t)(t.j0 + jj) * t.dst_ld + t.k0 + kb) = w; } } }
            __syncthreads();
            t = tn; job = nxt;
        }
    }
    bf16_t* U = (bf16_t*)(p.ws + WS_U);
    const int lane = tid & 63, gw = bid * 8 + (tid >> 6), nw = G * 8;
#define P0_ROWSRC(mm) ((const f32x4*)((mm) < NREAL ? p.x + (size_t)(mm) * DM : p.meta + (size_t)(((mm) - NREAL) & 15) * DM))
    f32x4 v[8];
#pragma unroll
    for (int i = 0; i < 8; ++i) v[i] = (f32x4){0.f, 0.f, 0.f, 0.f};
    if (gw < TOK) { const f32x4* src = P0_ROWSRC(gw);
#pragma unroll
        for (int i = 0; i < 8; ++i) v[i] = src[i * 64 + lane]; }
    for (int m = gw; m < MP; m += nw) {
        const int mn = m + nw; f32x4 vn[8];
#pragma unroll
        for (int i = 0; i < 8; ++i) vn[i] = (f32x4){0.f, 0.f, 0.f, 0.f};
        if (mn < TOK) { const f32x4* srcn = P0_ROWSRC(mn);
#pragma unroll
            for (int i = 0; i < 8; ++i) vn[i] = srcn[i * 64 + lane]; }
        u32x2* dst = (u32x2*)(U + (size_t)m * DM);
        if (m >= TOK) {
#pragma unroll
            for (int i = 0; i < 8; ++i) dst[i * 64 + lane] = (u32x2){0u, 0u};
        } else {
            float ss = 0.f;
#pragma unroll
            for (int i = 0; i < 8; ++i) ss += v[i][0] * v[i][0] + v[i][1] * v[i][1] + v[i][2] * v[i][2] + v[i][3] * v[i][3];
#pragma unroll
            for (int o = 32; o >= 1; o >>= 1) ss += __shfl_xor(ss, o);
            const float sc = rsqrtf(ss * (1.f / DM) + 1e-6f);
#pragma unroll
            for (int i = 0; i < 8; ++i) { const f32x4 nw4 = ((const f32x4*)p.norm_w)[i * 64 + lane];
                dst[i * 64 + lane] = (u32x2){cvt_pk_bf16(v[i][0] * sc * nw4[0], v[i][1] * sc * nw4[1]), cvt_pk_bf16(v[i][2] * sc * nw4[2], v[i][3] * sc * nw4[3])}; }
        }
#pragma unroll
        for (int i = 0; i < 8; ++i) v[i] = vn[i];
    }
#undef P0_ROWSRC
}

__device__ __forceinline__ void phase_final(const Params& p) {
    const float* rowss = (const float*)(p.ws + WS_ROWSS);
    const int tid = opaque_tid(), lane = tid & 63;
    const f32x4* fw4 = (const f32x4*)p.fnorm_w;
    f32x4 w[8];
#pragma unroll
    for (int i = 0; i < 8; ++i) w[i] = fw4[i * 64 + lane];
    for (int row = blockIdx.x * 8 + (tid >> 6); row < NREAL; row += gridDim.x * 8) {
        float ss = lane < 32 ? rowss[(size_t)row * 32 + lane] : 0.f;
#pragma unroll
        for (int o = 16; o >= 1; o >>= 1) ss += __shfl_xor(ss, o);
        ss = __shfl(ss, 0);
        const float sc = rsqrtf(ss * (1.f / DM) + 1e-6f);
        f32x4* o4 = (f32x4*)(p.out + (size_t)row * DM);
        f32x4 v[8];
#pragma unroll
        for (int i = 0; i < 8; ++i) v[i] = o4[i * 64 + lane];
#pragma unroll
        for (int i = 0; i < 8; ++i) { v[i][0] *= sc * w[i][0]; v[i][1] *= sc * w[i][1]; v[i][2] *= sc * w[i][2]; v[i][3] *= sc * w[i][3]; o4[i * 64 + lane] = v[i]; }
    }
}

#define XB_TMO      128
#define XB_XCNT(j)  (256  + 64 * (j))
#define XB_XSUB(j)  (1280 + 64 * (j))
#define XB_XGEN(j)  (2304 + 64 * (j))
#define XB_TOP      3328
#define XB_TOPGEN   3392
#define XCD_BAR_WORDS 3456
#define XB_SPIN_CAP (1u << 18)

__device__ __forceinline__ unsigned xb_ld(unsigned* p)              { return __hip_atomic_load(p, __ATOMIC_RELAXED, __HIP_MEMORY_SCOPE_AGENT); }
__device__ __forceinline__ unsigned xb_add(unsigned* p, unsigned v) { return __hip_atomic_fetch_add(p, v, __ATOMIC_RELAXED, __HIP_MEMORY_SCOPE_AGENT); }
__device__ __forceinline__ unsigned xb_xcc_id() { return (unsigned)__builtin_amdgcn_s_getreg((3 << 11) | 20) & 0xFu; }
#define XB_SPIN(cond, bar) do { unsigned _sp = 0; while (cond) { __builtin_amdgcn_s_sleep(1); \
    if ((++_sp & 255u) == 0u) { if (xb_ld(&(bar)[XB_TMO])) break; if (_sp > XB_SPIN_CAP) { atomicAdd(&(bar)[XB_TMO], 1u); break; } } } } while (0)

struct XcdBarrier {
    unsigned* bar; unsigned x;
    volatile LAS unsigned* st;
};

__device__ __forceinline__ XcdBarrier xcd_barrier_post(unsigned* bar, volatile LAS unsigned* st) {
    XcdBarrier b; b.bar = bar; b.x = xb_xcc_id(); b.st = st;
    if (threadIdx.x == 0) (void)xb_add(&bar[XB_XCNT(b.x)], 1u);
    return b;
}
__device__ __forceinline__ void xcd_barrier_complete(unsigned* bar, unsigned x, unsigned& nloc, unsigned& nx) {
    const unsigned G = gridDim.x * gridDim.y * gridDim.z;
    unsigned sum, cnt, mine, sp = 0u;
    for (;;) {
        sum = 0u; cnt = 0u; mine = 0u;
#pragma unroll
        for (unsigned j = 0; j < 16; ++j) { const unsigned c = xb_ld(&bar[XB_XCNT(j)]); sum += c; cnt += (c > 0u) ? 1u : 0u; mine = (j == x) ? c : mine; }
        if (sum == G) break;
        __builtin_amdgcn_s_sleep(1);
        if ((++sp & 255u) == 0u) { if (xb_ld(&bar[XB_TMO])) break; if (sp > XB_SPIN_CAP) { atomicAdd(&bar[XB_TMO], 1u); break; } }
    }
    nloc = mine > 0u ? mine : 1u; nx = cnt > 0u ? cnt : 1u;
}

__device__ __forceinline__ void xcd_barrier(const XcdBarrier& b) {
    asm volatile("s_waitcnt vmcnt(0)" ::: "memory");
    __syncthreads();
    if (threadIdx.x == 0) {
        unsigned* bar = b.bar;
        __builtin_amdgcn_s_waitcnt(0);
        unsigned nloc = b.st[0], nx = b.st[1];
        if (nloc == 0u) { xcd_barrier_complete(bar, b.x, nloc, nx); b.st[0] = nloc; b.st[1] = nx; }
        const unsigned old = xb_add(&bar[XB_XSUB(b.x)], 1u);
        const unsigned gen = old / nloc;
        if (old + 1u == (gen + 1u) * nloc) {
            __builtin_amdgcn_fence(__ATOMIC_RELEASE, "agent");
            asm volatile("s_waitcnt vmcnt(0)" ::: "memory");
            const unsigned og = xb_add(&bar[XB_TOP], 1u);
            const unsigned tg = og / nx;
            if (og + 1u == (tg + 1u) * nx) xb_add(&bar[XB_TOPGEN], 1u);
            else XB_SPIN(xb_ld(&bar[XB_TOPGEN]) == tg, bar);
            __builtin_amdgcn_fence(__ATOMIC_ACQUIRE, "agent");
            xb_add(&bar[XB_XGEN(b.x)], 1u);
            asm volatile("s_waitcnt vmcnt(0)" ::: "memory");
        } else {
            XB_SPIN(xb_ld(&bar[XB_XGEN(b.x)]) == gen, bar);
            __builtin_amdgcn_fence(__ATOMIC_ACQUIRE, "agent");
            asm volatile("s_waitcnt vmcnt(0)" ::: "memory");
        }
    }
    __syncthreads();
}


__device__ __forceinline__ void inverse64(float* Af, float* Zf, unsigned char* Tb, int tid) {
    const int lane = tid & 63, wave = tid >> 6;
    const int l15 = lane & 15, quad = lane >> 4;
    if (wave < 4) {
        const int o = wave * 16, col = l15;
        float t[16]; int roff = 0;
#pragma unroll
        for (int i = 0; i < 16; ++i) {
            if ((i & 1) == 0 && i >= 2) asm volatile("" : "+v"(roff) : "v"(t[i - 2]));
            float a0 = (i == col) ? 1.f : 0.f, a1 = 0.f, a2 = 0.f, a3 = 0.f;
#pragma unroll
            for (int j4 = 0; j4 < (i + 3) / 4; ++j4) { const f32x4 mv = *(const f32x4*)(Af + roff + (o + i) * 64 + o + j4 * 4);
                if (j4 * 4 + 0 < i) a0 -= mv[0] * t[j4 * 4 + 0];
                if (j4 * 4 + 1 < i) a1 -= mv[1] * t[j4 * 4 + 1];
                if (j4 * 4 + 2 < i) a2 -= mv[2] * t[j4 * 4 + 2];
                if (j4 * 4 + 3 < i) a3 -= mv[3] * t[j4 * 4 + 3]; }
            t[i] = (a0 + a1) + (a2 + a3);
        }
        asm volatile("s_waitcnt lgkmcnt(0)" ::: "memory");
        if (lane < 16) {
#pragma unroll
            for (int i = 0; i < 16; ++i) Af[(o + i) * 64 + o + col] = t[i]; }
    }
    __syncthreads();
    if (wave < 2) {
        const int o = wave * 32; f32x4 acc = {0.f, 0.f, 0.f, 0.f}, accb = {0.f, 0.f, 0.f, 0.f};
#pragma unroll
        for (int ks = 0; ks < 4; ++ks) { if (ks & 1) accb = __builtin_amdgcn_mfma_f32_16x16x4f32(Af[(o + 16 + l15) * 64 + o + ks * 4 + quad], Af[(o + ks * 4 + quad) * 64 + o + l15], accb, 0, 0, 0); else acc = __builtin_amdgcn_mfma_f32_16x16x4f32(Af[(o + 16 + l15) * 64 + o + ks * 4 + quad], Af[(o + ks * 4 + quad) * 64 + o + l15], acc, 0, 0, 0); }
        acc = acc + accb; accb = (f32x4){0.f, 0.f, 0.f, 0.f};
#pragma unroll
        for (int j = 0; j < 4; ++j) Zf[wave * 256 + (quad * 4 + j) * 16 + l15] = acc[j];
        asm volatile("s_waitcnt lgkmcnt(0)" ::: "memory");
        acc = (f32x4){0.f, 0.f, 0.f, 0.f};
#pragma unroll
        for (int ks = 0; ks < 4; ++ks) { if (ks & 1) accb = __builtin_amdgcn_mfma_f32_16x16x4f32(Af[(o + 16 + l15) * 64 + o + 16 + ks * 4 + quad], Zf[wave * 256 + (ks * 4 + quad) * 16 + l15], accb, 0, 0, 0); else acc = __builtin_amdgcn_mfma_f32_16x16x4f32(Af[(o + 16 + l15) * 64 + o + 16 + ks * 4 + quad], Zf[wave * 256 + (ks * 4 + quad) * 16 + l15], acc, 0, 0, 0); }
        acc = acc + accb; accb = (f32x4){0.f, 0.f, 0.f, 0.f};
#pragma unroll
        for (int j = 0; j < 4; ++j) Af[(o + 16 + quad * 4 + j) * 64 + o + l15] = -acc[j];
    }
    __syncthreads();
    const int ti = (wave >> 1) & 1, tj = wave & 1;
    if (wave < 4) {
        f32x4 acc = {0.f, 0.f, 0.f, 0.f}, accb = {0.f, 0.f, 0.f, 0.f};
#pragma unroll
        for (int ks = 0; ks < 8; ++ks) { if (ks & 1) accb = __builtin_amdgcn_mfma_f32_16x16x4f32(Af[(32 + ti * 16 + l15) * 64 + ks * 4 + quad], Af[(ks * 4 + quad) * 64 + tj * 16 + l15], accb, 0, 0, 0); else acc = __builtin_amdgcn_mfma_f32_16x16x4f32(Af[(32 + ti * 16 + l15) * 64 + ks * 4 + quad], Af[(ks * 4 + quad) * 64 + tj * 16 + l15], acc, 0, 0, 0); }
        acc = acc + accb; accb = (f32x4){0.f, 0.f, 0.f, 0.f};
#pragma unroll
        for (int j = 0; j < 4; ++j) Zf[(ti * 16 + quad * 4 + j) * 32 + tj * 16 + l15] = acc[j];
    }
    __syncthreads();
    if (wave < 4) {
        f32x4 acc = {0.f, 0.f, 0.f, 0.f}, accb = {0.f, 0.f, 0.f, 0.f};
#pragma unroll
        for (int ks = 0; ks < 8; ++ks) { if (ks & 1) accb = __builtin_amdgcn_mfma_f32_16x16x4f32(Af[(32 + ti * 16 + l15) * 64 + 32 + ks * 4 + quad], Zf[(ks * 4 + quad) * 32 + tj * 16 + l15], accb, 0, 0, 0); else acc = __builtin_amdgcn_mfma_f32_16x16x4f32(Af[(32 + ti * 16 + l15) * 64 + 32 + ks * 4 + quad], Zf[(ks * 4 + quad) * 32 + tj * 16 + l15], acc, 0, 0, 0); }
        acc = acc + accb; accb = (f32x4){0.f, 0.f, 0.f, 0.f};
#pragma unroll
        for (int j = 0; j < 4; ++j) Af[(32 + ti * 16 + quad * 4 + j) * 64 + tj * 16 + l15] = -acc[j];
    }
    __syncthreads();
    {   const int row = tid >> 3, c0 = (tid & 7) * 8;
        const f32x4 v0 = *(const f32x4*)(Af + row * 64 + c0), v1 = *(const f32x4*)(Af + row * 64 + c0 + 4);
        u32x4 w; w.x = cvt_pk_bf16(v0[0], v0[1]); w.y = cvt_pk_bf16(v0[2], v0[3]); w.z = cvt_pk_bf16(v1[0], v1[1]); w.w = cvt_pk_bf16(v1[2], v1[3]);
        *(u32x4*)(Tb + (row * 72 + c0) * 2) = w; }
    __syncthreads();
}
__device__ __forceinline__ bf16x8 gather8c(const unsigned char* base, int ld, int r0, int c0, int l15, int quad) {
    const int lo = (quad * 8 * ld + l15) * 2;
    bf16x8 g;
#pragma unroll
    for (int i = 0; i < 8; ++i) g[i] = *(const short*)(base + lo + ((r0 + i) * ld + c0) * 2);
    return g;
}

struct DnIn { u32x4 x[11]; float bb, aa; };
__device__ __forceinline__ void dn_load(const Params& p, int job, DnIn& in, int tid) {
    const bf16_t* P = (const bf16_t*)(p.ws + WS_P);
    const int bh = job / NCH, n = job % NCH, b = bh >> 3, h = bh & 7;
    in.bb = 0.f; in.aa = 0.f;
    if (tid < 64) { const int tp = n * 64 + tid - 48;
        if (tp >= 0) { const size_t m = (size_t)rowof(b, tp) * NP; in.bb = bf2f(P[m + C_DB + h]); in.aa = bf2f(P[m + C_DA + h]); } }
    const int grp = tid >> 4, g8 = tid & 15;
#pragma unroll
    for (int i = 0; i < 11; ++i) in.x[i] = (u32x4){0u, 0u, 0u, 0u};
    if (grp < 24) { const int which = grp >> 3, c0 = (grp & 7) * 8, chn = which * 1024 + h * 128 + g8 * 8, tp0 = n * 64 + c0 - 48;
#pragma unroll
        for (int i = 0; i < 11; ++i) { const int tpi = tp0 - 3 + i; if (tpi >= 0) in.x[i] = *(const u32x4*)(P + (size_t)rowof(b, tpi) * NP + C_DQ + chn); } }
}
__device__ __forceinline__ void dn_prep(const Params& p, int job, unsigned char* lds, DnIn& in, int next_job) {
    const int bh = job / NCH, n = job % NCH, b = bh >> 3, h = bh & 7;
    const int tid = opaque_tid(), lane = tid & 63, wave = tid >> 6, l15 = lane & 15, quad = lane >> 4;
    const bf16_t* P = (const bf16_t*)(p.ws + WS_P);
    unsigned char* blk = p.ws + WS_DNP + (size_t)job * DNP_BLK;
    bf16_t* gW = (bf16_t*)blk; bf16_t* gQG = (bf16_t*)(blk + 16384); bf16_t* gKDT = (bf16_t*)(blk + 32768); bf16_t* gAT = (bf16_t*)(blk + 49152); bf16_t* gU = (bf16_t*)(blk + 57344);
    unsigned char* Kn = lds; unsigned char* Kb = lds + 17408; unsigned char* Qs = lds + 34816; unsigned char* Vb = lds + 52224; unsigned char* Kbg = lds + 69632; unsigned char* Kd = lds + 87040;
    float* Mf = (float*)(lds + 104448); unsigned char* Tb = lds + 120832; float* Gs = (float*)(lds + 130048);
    if (tid < 64) {
        const int tp = n * 64 + tid - 48; float gl = 0.f, bt = 0.f;
        if (tp >= 0) { bt = sigmoidf_(in.bb); gl = -__expf(p.A_log[h]) * softplusf_(in.aa + p.dt_bias[h]); }
#pragma unroll
        for (int off = 1; off < 64; off <<= 1) { const float t = __shfl_up(gl, off); if (lane >= off) gl += t; }
        Gs[tid] = gl; Gs[64 + tid] = bt;
    }
    __syncthreads();
    const float glast = Gs[63];
    if (tid == 0) ((float*)(p.ws + WS_DNG))[job] = __expf(glast);
    {
        const int grp = tid >> 4, g8 = tid & 15;
        if (grp < 24) {
            const int which = grp >> 3, c0 = (grp & 7) * 8, chn = which * 1024 + h * 128 + g8 * 8, tp0 = n * 64 + c0 - 48;
            f32x4 cw[4][2];
#pragma unroll
            for (int i = 0; i < 4; ++i) { cw[i][0] = *(const f32x4*)(p.conv_w + (size_t)i * 3072 + chn); cw[i][1] = *(const f32x4*)(p.conv_w + (size_t)i * 3072 + chn + 4); }
#pragma unroll
            for (int cc = 0; cc < 8; ++cc) {
                const int c = c0 + cc; float acc[8];
#pragma unroll
                for (int e = 0; e < 8; ++e) acc[e] = 0.f;
#pragma unroll
                for (int i = 0; i < 4; ++i) { const u32x4 xv = in.x[cc + i];
                    acc[0] += cw[i][0][0] * bf_lo(xv.x); acc[1] += cw[i][0][1] * bf_hi(xv.x); acc[2] += cw[i][0][2] * bf_lo(xv.y); acc[3] += cw[i][0][3] * bf_hi(xv.y);
                    acc[4] += cw[i][1][0] * bf_lo(xv.z); acc[5] += cw[i][1][1] * bf_hi(xv.z); acc[6] += cw[i][1][2] * bf_lo(xv.w); acc[7] += cw[i][1][3] * bf_hi(xv.w); }
                if (tp0 >= 0) {
#pragma unroll
                    for (int e = 0; e < 8; ++e) acc[e] = siluf_(acc[e]); }
                else {
#pragma unroll
                    for (int e = 0; e < 8; ++e) acc[e] = 0.f; }
                float ss = 0.f;
#pragma unroll
                for (int e = 0; e < 8; ++e) ss += acc[e] * acc[e];
                ss = sum16(ss);
                const float inv = rsqrtf(ss + 1e-6f);
                const float gc = Gs[c], bt = Gs[64 + c];
                const int lo = (c * 136 + g8 * 8) * 2;
#define PK8(dstp, sc) do { const float _s = (sc); u32x4 _w; _w.x = cvt_pk_bf16(acc[0] * _s, acc[1] * _s); _w.y = cvt_pk_bf16(acc[2] * _s, acc[3] * _s); \
        _w.z = cvt_pk_bf16(acc[4] * _s, acc[5] * _s); _w.w = cvt_pk_bf16(acc[6] * _s, acc[7] * _s); *(u32x4*)(dstp) = _w; } while (0)
                if (which == 0) { const float sc = inv * 0.08838834764831845f; PK8(Qs + lo, sc); PK8(gQG + c * 128 + g8 * 8, sc * __expf(gc)); }
                else if (which == 1) { PK8(Kn + lo, inv); PK8(Kb + lo, inv * bt); PK8(Kbg + lo, inv * bt * __expf(gc)); PK8(Kd + lo, inv * __expf(glast - gc)); }
                else { PK8(Vb + lo, bt); }
#undef PK8
            }
        }
    }
    if (next_job >= 0) dn_load(p, next_job, in, tid);
    __syncthreads();
#pragma unroll 1
    for (int i = 0; i < 4; ++i) {
        const int tile = wave * 4 + i;
        f32x4 acc = {0.f, 0.f, 0.f, 0.f};
        if (tile < 16) { const int ct = tile >> 2, st = tile & 3;
            bf16x8 fa[4], fb[4]; f32x4 acc2 = {0.f, 0.f, 0.f, 0.f};
#pragma unroll
            for (int ks = 0; ks < 4; ++ks) { fa[ks] = ldfrag(Kb, 136, ct * 16, ks * 32, lane); fb[ks] = ldfrag(Kn, 136, st * 16, ks * 32, lane); }
            acc = MFMA16(fa[0], fb[0], acc); acc2 = MFMA16(fa[1], fb[1], acc2); acc = MFMA16(fa[2], fb[2], acc); acc2 = MFMA16(fa[3], fb[3], acc2);
            acc = acc + acc2;
            const int s = st * 16 + l15; const float gs = Gs[s];
#pragma unroll
            for (int j = 0; j < 4; ++j) { const int c = ct * 16 + quad * 4 + j; Mf[c * 64 + s] = (s < c) ? acc[j] * __expf(Gs[c] - gs) : 0.f; }
        } else { const int t2 = tile - 16, st = t2 >> 2, ct = t2 & 3;
            bf16x8 fa[4], fb[4]; f32x4 acc2 = {0.f, 0.f, 0.f, 0.f};
#pragma unroll
            for (int ks = 0; ks < 4; ++ks) { fa[ks] = ldfrag(Kn, 136, st * 16, ks * 32, lane); fb[ks] = ldfrag(Qs, 136, ct * 16, ks * 32, lane); }
            acc = MFMA16(fa[0], fb[0], acc); acc2 = MFMA16(fa[1], fb[1], acc2); acc = MFMA16(fa[2], fb[2], acc); acc2 = MFMA16(fa[3], fb[3], acc2);
            acc = acc + acc2;
            const int c = ct * 16 + l15; const float gc = Gs[c]; float v[4];
#pragma unroll
            for (int j = 0; j < 4; ++j) { const int s = st * 16 + quad * 4 + j; v[j] = (s <= c) ? acc[j] * __expf(gc - Gs[s]) : 0.f; }
            *(u32x2*)(gAT + c * 64 + st * 16 + quad * 4) = (u32x2){cvt_pk_bf16(v[0], v[1]), cvt_pk_bf16(v[2], v[3])};
        }
    }
    __syncthreads();
    inverse64(Mf, (float*)(lds + 130560), Tb, tid);
    {
        const int dt = wave;
        bf16x8 GV[2], GK[2];
#pragma unroll
        for (int ks = 0; ks < 2; ++ks)
#pragma unroll
            for (int i = 0; i < 8; ++i) { const int lo = (quad * 8 * 136 + dt * 16 + l15) * 2, off = (ks * 32 + i) * 136 * 2;
                GV[ks][i] = *(const short*)(Vb + lo + off); GK[ks][i] = *(const short*)(Kbg + lo + off); }
        bf16x8 tfr[4][2]; f32x4 aus[4], aws[4];
#pragma unroll
        for (int ct = 0; ct < 4; ++ct) { tfr[ct][0] = ldfrag(Tb, 72, ct * 16, 0, lane); tfr[ct][1] = ldfrag(Tb, 72, ct * 16, 32, lane); }
#pragma unroll
        for (int ct = 0; ct < 4; ++ct) { aus[ct] = MFMA16(tfr[ct][0], GV[0], ((f32x4){0.f, 0.f, 0.f, 0.f})); aws[ct] = MFMA16(GK[0], tfr[ct][0], ((f32x4){0.f, 0.f, 0.f, 0.f})); }
#pragma unroll
        for (int ct = 0; ct < 4; ++ct) { aus[ct] = MFMA16(tfr[ct][1], GV[1], aus[ct]); aws[ct] = MFMA16(GK[1], tfr[ct][1], aws[ct]); }
#pragma unroll
        for (int ct = 0; ct < 4; ++ct) {
            const f32x4 au = aus[ct], aw = aws[ct];
            *(u32x2*)(gU + ((ct * 8 + dt) * 64 + lane) * 4) = (u32x2){cvt_pk_bf16(au[0], au[1]), cvt_pk_bf16(au[2], au[3])};
            *(u32x2*)(gW + (ct * 16 + l15) * 128 + dt * 16 + quad * 4) = (u32x2){cvt_pk_bf16(-aw[0], -aw[1]), cvt_pk_bf16(-aw[2], -aw[3])};
        }
        const int k = tid & 127, cbq = tid >> 7;
#pragma unroll
        for (int rr = 0; rr < 2; ++rr) { const int cb = cbq + rr * 4; unsigned v[8];
#pragma unroll
            for (int i = 0; i < 8; ++i) v[i] = *(const bf16_t*)(Kd + ((cb * 8 + i) * 136 + k) * 2);
            u32x4 w; w.x = v[0] | (v[1] << 16); w.y = v[2] | (v[3] << 16); w.z = v[4] | (v[5] << 16); w.w = v[6] | (v[7] << 16);
            *(u32x4*)(gKDT + k * 64 + cb * 8) = w; }
    }
    __syncthreads();
}

constexpr int DN_PARTS = 4, DN_VPW = 8 / DN_PARTS;
constexpr size_t DN_ORAW_OFF = (size_t)64 << 20;
struct DnSet { u32x4 pw[2], pq[2], pk[2], pa; u32x2 pu[4]; float dec; };
__device__ __forceinline__ void dn_fetch(const Params& p, DnSet& s, int bh, int n, int tid, int vt, int lane) {
    const unsigned char* blk = p.ws + WS_DNP + (size_t)(bh * NCH + n) * DNP_BLK;
#pragma unroll
    for (int i = 0; i < 2; ++i) { const int id = tid + 512 * i; s.pw[i] = *(const u32x4*)(blk + id * 16); s.pq[i] = *(const u32x4*)(blk + 16384 + id * 16); s.pk[i] = *(const u32x4*)(blk + 32768 + id * 16); }
    s.pa = *(const u32x4*)(blk + 49152 + tid * 16);
#pragma unroll
    for (int ct = 0; ct < 4; ++ct) s.pu[ct] = *(const u32x2*)(blk + 57344 + (((ct * 8 + vt) * 64 + lane) * 8));
    s.dec = ((const float*)(p.ws + WS_DNG))[bh * NCH + n];
}
__device__ __forceinline__ void dn_chunk(const Params& p, DnSet& s, f32x4 (&S)[8], int bh, int n, int tid, int wave, int lane, int l15, int quad, bool mf, int vt, unsigned char* lds) {
    unsigned char* Wl = lds; unsigned char* QGl = lds + 17408; unsigned char* KDl = lds + 34816; unsigned char* ATl = lds + 53248;
    unsigned char* St = lds + 62464 + (wave & (DN_VPW - 1)) * 4352; unsigned char* Vt = lds + 97280 + (wave & (DN_VPW - 1)) * 2304;
    __syncthreads();
#pragma unroll
    for (int i = 0; i < 2; ++i) { const int id = tid + 512 * i;
        *(u32x4*)(Wl + ((id >> 4) * 136 + (id & 15) * 8) * 2) = s.pw[i]; *(u32x4*)(QGl + ((id >> 4) * 136 + (id & 15) * 8) * 2) = s.pq[i];
        *(u32x4*)(KDl + ((id >> 3) * 72 + (id & 7) * 8) * 2) = s.pk[i]; }
    *(u32x4*)(ATl + ((tid >> 3) * 72 + (tid & 7) * 8) * 2) = s.pa;
    f32x4 vn[4];
#pragma unroll
    for (int ct = 0; ct < 4; ++ct) vn[ct] = (f32x4){bf_lo(s.pu[ct].x), bf_hi(s.pu[ct].x), bf_lo(s.pu[ct].y), bf_hi(s.pu[ct].y)};
    const float dec = s.dec;
    __syncthreads();
    if (n + 2 < NCH) dn_fetch(p, s, bh, n + 2, tid, vt, lane);
    {
        unsigned char* ogl = (unsigned char*)p.out + DN_ORAW_OFF + (size_t)(bh * NCH + n) * 16384;
        if (mf) {
#pragma unroll
        for (int kt = 0; kt < 8; ++kt) *(u32x2*)(St + (l15 * 136 + kt * 16 + quad * 4) * 2) = (u32x2){cvt_pk_bf16(S[kt][0], S[kt][1]), cvt_pk_bf16(S[kt][2], S[kt][3])};
        asm volatile("s_waitcnt lgkmcnt(0)" ::: "memory");
        bf16x8 sf[4];
#pragma unroll
        for (int ks = 0; ks < 4; ++ks) sf[ks] = ldfrag(St, 136, 0, ks * 32, lane);
        {   bf16x8 fa[4], fb[4];
#pragma unroll
            for (int ct = 0; ct < 4; ++ct) fa[ct] = ldfrag(Wl, 136, ct * 16, 0, lane);
#pragma unroll
            for (int ks = 0; ks < 4; ++ks) {
                if (ks + 1 < 4) {
#pragma unroll
                    for (int ct = 0; ct < 4; ++ct) { if (ks & 1) fa[ct] = ldfrag(Wl, 136, ct * 16, (ks + 1) * 32, lane); else fb[ct] = ldfrag(Wl, 136, ct * 16, (ks + 1) * 32, lane); } }
#pragma unroll
                for (int ct = 0; ct < 4; ++ct) vn[ct] = MFMA16((ks & 1) ? fb[ct] : fa[ct], sf[ks], vn[ct]);
            } }
#pragma unroll
        for (int ct = 0; ct < 4; ++ct) *(u32x2*)(Vt + (l15 * 72 + ct * 16 + quad * 4) * 2) = (u32x2){cvt_pk_bf16(vn[ct][0], vn[ct][1]), cvt_pk_bf16(vn[ct][2], vn[ct][3])};
        asm volatile("s_waitcnt lgkmcnt(0)" ::: "memory");
        bf16x8 vf[2];
#pragma unroll
        for (int ks = 0; ks < 2; ++ks) vf[ks] = ldfrag(Vt, 72, 0, ks * 32, lane);
        {   f32x4 o[4]; bf16x8 fa[4], fb[4];
#pragma unroll
            for (int ct = 0; ct < 4; ++ct) { o[ct] = (f32x4){0.f, 0.f, 0.f, 0.f}; fa[ct] = ldfrag(QGl, 136, ct * 16, 0, lane); }
#pragma unroll
            for (int ks = 0; ks < 6; ++ks) {
                if (ks + 1 < 6) {
#pragma unroll
                    for (int ct = 0; ct < 4; ++ct) { const bf16x8 f = (ks + 1 < 4) ? ldfrag(QGl, 136, ct * 16, (ks + 1) * 32, lane) : ldfrag(ATl, 72, ct * 16, (ks + 1 - 4) * 32, lane);
                        if (ks & 1) fa[ct] = f; else fb[ct] = f; } }
#pragma unroll
                for (int ct = 0; ct < 4; ++ct) o[ct] = MFMA16(ks < 4 ? sf[ks] : vf[ks - 4], (ks & 1) ? fb[ct] : fa[ct], o[ct]);
            }
#pragma unroll
            for (int ct = 0; ct < 4; ++ct)
                *(u32x2*)(ogl + ((ct * 16 + l15) * 128 + vt * 16 + quad * 4) * 2) = (u32x2){cvt_pk_bf16(o[ct][0], o[ct][1]), cvt_pk_bf16(o[ct][2], o[ct][3])}; }
        {   bf16x8 fa[8], fb[8];
#pragma unroll
            for (int kt = 0; kt < 8; ++kt) { fa[kt] = ldfrag(KDl, 72, kt * 16, 0, lane); S[kt] = S[kt] * dec; }
#pragma unroll
            for (int kt = 0; kt < 8; ++kt) fb[kt] = ldfrag(KDl, 72, kt * 16, 32, lane);
#pragma unroll
            for (int kt = 0; kt < 8; ++kt) S[kt] = MFMA16(fa[kt], vf[0], S[kt]);
#pragma unroll
            for (int kt = 0; kt < 8; ++kt) S[kt] = MFMA16(fb[kt], vf[1], S[kt]);
        }
        }
    }
}
__device__ __forceinline__ void dn_scan(const Params& p, int bh, int part, unsigned char* lds) {
    const int tid = opaque_tid(), lane = tid & 63, wave = tid >> 6, l15 = lane & 15, quad = lane >> 4;
    const bool mf = wave < DN_VPW; const int vt = part * DN_VPW + (wave & (DN_VPW - 1));
    f32x4 S[8];
#pragma unroll
    for (int i = 0; i < 8; ++i) S[i] = (f32x4){0.f, 0.f, 0.f, 0.f};
    DnSet s0, s1;
    dn_fetch(p, s0, bh, 0, tid, vt, lane);
    dn_fetch(p, s1, bh, 1, tid, vt, lane);
#pragma unroll 1
    for (int n = 0; n + 3 < NCH; n += 4) {
        dn_chunk(p, s0, S, bh, n, tid, wave, lane, l15, quad, mf, vt, lds);
        dn_chunk(p, s1, S, bh, n + 1, tid, wave, lane, l15, quad, mf, vt, lds);
        dn_chunk(p, s0, S, bh, n + 2, tid, wave, lane, l15, quad, mf, vt, lds);
        dn_chunk(p, s1, S, bh, n + 3, tid, wave, lane, l15, quad, mf, vt, lds);
    }
    static_assert(NCH % 4 == 1, "tail below handles exactly one chunk");
    dn_chunk(p, s0, S, bh, NCH - 1, tid, wave, lane, l15, quad, mf, vt, lds);
}


struct DnPostIn { u32x4 o0, o1, z0, z1; };
__device__ __forceinline__ void dn_post_load(const Params& p, int job, DnPostIn& in, int tid) {
    const int bh = job / NCH, n = job % NCH, b = bh >> 3, h = bh & 7;
    const int pc = tid >> 3, pvg = tid & 7, tp = n * 64 + pc - 48;
    const bf16_t* P = (const bf16_t*)(p.ws + WS_P);
    const unsigned char* op = (const unsigned char*)p.out + DN_ORAW_OFF + (size_t)job * 16384 + (pc * 128 + pvg * 16) * 2;
    const bf16_t* zp = P + (size_t)rowof(b, tp < 0 ? 0 : tp) * NP + C_Z + h * 128 + pvg * 16;
    in.o0 = ((const u32x4*)op)[0]; in.o1 = ((const u32x4*)op)[1]; in.z0 = ((const u32x4*)zp)[0]; in.z1 = ((const u32x4*)zp)[1];
}
__device__ __forceinline__ void dn_post(const Params& p, int job, const DnPostIn& in, int tid) {
    const int bh = job / NCH, n = job % NCH, b = bh >> 3, h = bh & 7;
    const int pc = tid >> 3, pvg = tid & 7, tp = n * 64 + pc - 48;
    bf16_t* P = (bf16_t*)(p.ws + WS_P);
    const bool valid = tp >= 0;
    bf16_t* zp = P + (size_t)rowof(b, valid ? tp : 0) * NP + C_Z + h * 128 + pvg * 16;
    const u32x4 o0 = in.o0, o1 = in.o1, z0 = in.z0, z1 = in.z1;
    const f32x4 nw0 = *(const f32x4*)(p.dn_norm_w + pvg * 16), nw1 = *(const f32x4*)(p.dn_norm_w + pvg * 16 + 4), nw2 = *(const f32x4*)(p.dn_norm_w + pvg * 16 + 8), nw3 = *(const f32x4*)(p.dn_norm_w + pvg * 16 + 12);
    const float nw[16] = {nw0[0], nw0[1], nw0[2], nw0[3], nw1[0], nw1[1], nw1[2], nw1[3], nw2[0], nw2[1], nw2[2], nw2[3], nw3[0], nw3[1], nw3[2], nw3[3]};
    float ov[16], zv[16];
#pragma unroll
    for (int e = 0; e < 4; ++e) { ov[2 * e] = bf_lo(o0[e]); ov[2 * e + 1] = bf_hi(o0[e]); ov[8 + 2 * e] = bf_lo(o1[e]); ov[8 + 2 * e + 1] = bf_hi(o1[e]);
        zv[2 * e] = bf_lo(z0[e]); zv[2 * e + 1] = bf_hi(z0[e]); zv[8 + 2 * e] = bf_lo(z1[e]); zv[8 + 2 * e + 1] = bf_hi(z1[e]); }
    float ss = 0.f;
#pragma unroll
    for (int e = 0; e < 16; ++e) ss += ov[e] * ov[e];
    ss = sum8(ss);
    const float inv = rsqrtf(ss * (1.f / 128.f) + 1e-6f);
    float r[16];
#pragma unroll
    for (int e = 0; e < 16; ++e) r[e] = ov[e] * inv * nw[e] * siluf_(zv[e]);
    if (valid) { u32x4 w0, w1;
        w0.x = cvt_pk_bf16(r[0], r[1]); w0.y = cvt_pk_bf16(r[2], r[3]); w0.z = cvt_pk_bf16(r[4], r[5]); w0.w = cvt_pk_bf16(r[6], r[7]);
        w1.x = cvt_pk_bf16(r[8], r[9]); w1.y = cvt_pk_bf16(r[10], r[11]); w1.z = cvt_pk_bf16(r[12], r[13]); w1.w = cvt_pk_bf16(r[14], r[15]);
        ((u32x4*)zp)[0] = w0; ((u32x4*)zp)[1] = w1; }
}

constexpr size_t RWP_BLK = 33792;
constexpr int RWP_SPLIT = 2296;
__device__ __forceinline__ unsigned char* rwp_ptr(const Params& p, int job) {
    return job < RWP_SPLIT ? p.ws + WS_RWP + (size_t)job * RWP_BLK : (unsigned char*)p.out + (size_t)(job - RWP_SPLIT) * RWP_BLK;
}
#define PACK4(a) ((u32x2){cvt_pk_bf16((a)[0], (a)[1]), cvt_pk_bf16((a)[2], (a)[3])})


struct RwIn { u32x4 lc[2], lq[2], cr, ck, cv, qr, qk, qv; bf16x8 A1[2], A2[2]; f32x4 w0v, a0v; f32x4 mul[4]; };
__device__ __forceinline__ void rw_load(const Params& p, int job, RwIn& in, int tid) {
    const bf16_t* P = (const bf16_t*)(p.ws + WS_P);
    const int bh = job / NCH, n = job % NCH, b = bh >> 4, h = bh & 15;
    const u32x4 z = {0u, 0u, 0u, 0u};
    in.lc[0] = z; in.lc[1] = z; in.lq[0] = z; in.lq[1] = z; in.cr = z; in.ck = z; in.cv = z; in.qr = z; in.qk = z; in.qv = z;
    const int tp = n * 64 + (tid >> 3) - 48, cs = (tid & 7) * 16, chn3 = h * 64 + (tid & 7) * 8;
    {
        const int lane = tid & 63, wave = tid >> 6, l15 = lane & 15, quad = lane >> 4, chl = (wave & 3) * 16;
        const bf16_t* W2T = (const bf16_t*)(p.ws + WS_W2T); const bf16_t* A2T = (const bf16_t*)(p.ws + WS_A2T);
#pragma unroll
        for (int ks = 0; ks < 2; ++ks) { in.A1[ks] = *(const bf16x8*)(W2T + (size_t)(h * 64 + chl + l15) * 64 + ks * 32 + quad * 8); in.A2[ks] = *(const bf16x8*)(A2T + (size_t)(h * 64 + chl + l15) * 64 + ks * 32 + quad * 8); }
        const int ch = h * 64 + chl + quad * 4;
        in.w0v = *(const f32x4*)(p.w0 + ch); in.a0v = *(const f32x4*)(p.a0 + ch);
    }
    if (tp >= 0) {
        const bf16_t* rp = P + (size_t)rowof(b, tp) * NP;
        in.lc[0] = *(const u32x4*)(rp + C_LW + cs); in.lc[1] = *(const u32x4*)(rp + C_LW + cs + 8);
        in.cr = *(const u32x4*)(rp + chn3 + C_R); in.ck = *(const u32x4*)(rp + chn3 + C_K); in.cv = *(const u32x4*)(rp + chn3 + C_V);
        if (tp > 0) { const bf16_t* pp = P + (size_t)rowof(b, tp - 1) * NP;
            in.lq[0] = *(const u32x4*)(pp + C_LW + cs); in.lq[1] = *(const u32x4*)(pp + C_LW + cs + 8);
            in.qr = *(const u32x4*)(pp + chn3 + C_R); in.qk = *(const u32x4*)(pp + chn3 + C_K); in.qv = *(const u32x4*)(pp + chn3 + C_V); } }
}
__device__ __forceinline__ void rw_prep(const Params& p, int job, unsigned char* lds, RwIn& in, int next_job) {
    const int bh = job / NCH, n = job % NCH, b = bh >> 4, h = bh & 15;
    const int tid = opaque_tid(), lane = tid & 63, wave = tid >> 6, l15 = lane & 15, quad = lane >> 4;
    const bf16_t* P = (const bf16_t*)(p.ws + WS_P);
    unsigned char* blk = rwp_ptr(p, job);
    bf16_t* gQ = (bf16_t*)blk; bf16_t* gF = (bf16_t*)(blk + 8192); bf16_t* gY0 = (bf16_t*)(blk + 16384); bf16_t* gS0 = (bf16_t*)(blk + 24576);
    float* gWC = (float*)(blk + 32768); float* gBS = (float*)(blk + 33024);
    unsigned char* sKap = lds; unsigned char* sBet = lds + 9216; unsigned char* sKti = lds + 18432; unsigned char* sRho = lds + 27648; unsigned char* sBd = lds + 36864;
    unsigned char* sKd = lds + 46080; unsigned char* sV = lds + 55296; unsigned char* sBm = lds + 64512; unsigned char* sAb = lds + 73728; unsigned char* sAk = lds + 82944; unsigned char* sT = lds + 92160;
    unsigned char* sP1 = sBet; unsigned char* sX = sKti; unsigned char* sP2 = sBm;
    float* Af = (float*)(lds + 101376);
    float* AA = (float*)(lds + 64512);
    float* Zf = (float*)(lds + 117760);
    unsigned char* X1 = lds + 121856; unsigned char* X2 = lds + 131072;
    float* WC = (float*)(lds + 140288);
    const int t3 = tid >> 3, c8 = (tid & 7) * 8, chn3 = h * 64 + c8;
    f32x4 cmr[2], cmk[2], cmv[2], ckk[2], cka[2], crk[2];
#pragma unroll
    for (int i = 0; i < 2; ++i) { cmr[i] = *(const f32x4*)(p.mu + C_R + chn3 + 4 * i); cmk[i] = *(const f32x4*)(p.mu + C_K + chn3 + 4 * i); cmv[i] = *(const f32x4*)(p.mu + C_V + chn3 + 4 * i);
        ckk[i] = *(const f32x4*)(p.k_k + chn3 + 4 * i); cka[i] = *(const f32x4*)(p.k_a + chn3 + 4 * i); crk[i] = *(const f32x4*)(p.r_k + chn3 + 4 * i); }
    {
        const int tok = tid >> 3, cs = (tid & 7) * 16;
        const u32x4 c[2] = {in.lc[0], in.lc[1]}, q[2] = {in.lq[0], in.lq[1]};
        float v[16];
#pragma unroll
        for (int i = 0; i < 2; ++i)
#pragma unroll
            for (int e = 0; e < 4; ++e) { const unsigned cw = c[i][e], qw = q[i][e];
                const float c0 = bf_lo(cw), c1 = bf_hi(cw), q0 = bf_lo(qw), q1 = bf_hi(qw);
                const int idx = i * 8 + e * 2; const float mu0 = in.mul[idx >> 2][idx & 3], mu1 = in.mul[(idx + 1) >> 2][(idx + 1) & 3];
                v[idx] = c0 + (q0 - c0) * mu0; v[idx + 1] = c1 + (q1 - c1) * mu1; }
        if (cs < 64) {
#pragma unroll
            for (int i = 0; i < 16; ++i) { const float e2 = __expf(2.f * v[i]); v[i] = 1.f - 2.f * __builtin_amdgcn_rcpf(e2 + 1.f); } }
        unsigned char* dst = (cs < 64 ? X1 : X2) + (tok * 72 + (cs & 63)) * 2;
        u32x4 w0, w1;
        w0.x = cvt_pk_bf16(v[0], v[1]); w0.y = cvt_pk_bf16(v[2], v[3]); w0.z = cvt_pk_bf16(v[4], v[5]); w0.w = cvt_pk_bf16(v[6], v[7]);
        w1.x = cvt_pk_bf16(v[8], v[9]); w1.y = cvt_pk_bf16(v[10], v[11]); w1.z = cvt_pk_bf16(v[12], v[13]); w1.w = cvt_pk_bf16(v[14], v[15]);
        ((u32x4*)dst)[0] = w0; ((u32x4*)dst)[1] = w1;
    }
    __syncthreads();
    {
        const int chl = (wave & 3) * 16, tt0 = (wave >> 2) * 2;
        const bf16x8 A1[2] = {in.A1[0], in.A1[1]}, A2[2] = {in.A2[0], in.A2[1]}; const f32x4 w0v = in.w0v, a0v = in.a0v;
        bf16x8 xf1[2][2], xf2[2][2];
#pragma unroll
        for (int q = 0; q < 2; ++q)
#pragma unroll
            for (int ks = 0; ks < 2; ++ks) { xf1[q][ks] = ldfrag(X1, 72, (tt0 + q) * 16, ks * 32, lane); xf2[q][ks] = ldfrag(X2, 72, (tt0 + q) * 16, ks * 32, lane); }
#pragma unroll
        for (int q = 0; q < 2; ++q) { const int tt = tt0 + q;
            f32x4 acc1 = {0.f, 0.f, 0.f, 0.f}, acc2 = {0.f, 0.f, 0.f, 0.f};
#pragma unroll
            for (int ks = 0; ks < 2; ++ks) { acc1 = MFMA16(A1[ks], xf1[q][ks], acc1); acc2 = MFMA16(A2[ks], xf2[q][ks], acc2); }
            const int tok = tt * 16 + l15; const bool nul = (n * 64 + tok - 48) < 0;
            f32x4 ew, av;
#pragma unroll
            for (int j = 0; j < 4; ++j) { ew[j] = nul ? 0.f : 0.6065306597f * sigmoidf_(w0v[j] + acc1[j]); av[j] = sigmoidf_(a0v[j] + acc2[j]); }
            *(f32x4*)(Af + tok * 64 + chl + quad * 4) = ew; *(f32x4*)(AA + tok * 64 + chl + quad * 4) = av;
        }
    }
    __syncthreads();
    {
        const int ch = tid & 63, seg = tid >> 6;
        float e[8], s = 0.f;
#pragma unroll
        for (int i = 0; i < 8; ++i) { e[i] = Af[(seg * 8 + i) * 64 + ch]; s += e[i]; }
        Zf[seg * 64 + ch] = s;
        __syncthreads();
        float pre = 0.f;
#pragma unroll
        for (int s2 = 0; s2 < 7; ++s2) pre += (s2 < seg) ? Zf[s2 * 64 + ch] : 0.f;
#pragma unroll
        for (int i = 0; i < 8; ++i) { pre += e[i]; Af[(seg * 8 + i) * 64 + ch] = -pre; }
        if (seg == 7) { const float wc = __expf(-pre); WC[ch] = wc; gWC[ch] = wc; }
    }
    __syncthreads();
    {
        const int t = t3;
        const u32x4 cr = in.cr, ck = in.ck, cv = in.cv, qr = in.qr, qk = in.qk, qv = in.qv;
        float r[8], k[8], v[8];
#pragma unroll
        for (int e = 0; e < 4; ++e) {
            const int i = e >> 1, j0 = (2 * e) & 3;
            float c0 = bf_lo(cr[e]), c1 = bf_hi(cr[e]); r[2 * e] = c0 + (bf_lo(qr[e]) - c0) * cmr[i][j0]; r[2 * e + 1] = c1 + (bf_hi(qr[e]) - c1) * cmr[i][j0 + 1];
            c0 = bf_lo(ck[e]); c1 = bf_hi(ck[e]); k[2 * e] = c0 + (bf_lo(qk[e]) - c0) * cmk[i][j0]; k[2 * e + 1] = c1 + (bf_hi(qk[e]) - c1) * cmk[i][j0 + 1];
            c0 = bf_lo(cv[e]); c1 = bf_hi(cv[e]); v[2 * e] = c0 + (bf_lo(qv[e]) - c0) * cmv[i][j0]; v[2 * e + 1] = c1 + (bf_hi(qv[e]) - c1) * cmv[i][j0 + 1]; }
        float kn[8], km[8], bb[8], ss = 0.f, bs = 0.f;
#pragma unroll
        for (int e = 0; e < 8; ++e) { const float a = AA[t * 64 + c8 + e]; kn[e] = k[e] * ckk[e >> 2][e & 3]; ss += kn[e] * kn[e];
            km[e] = k[e] * (1.f + (a - 1.f) * cka[e >> 2][e & 3]); bb[e] = a; bs += r[e] * km[e] * crk[e >> 2][e & 3]; }
        ss = sum8(ss); bs = sum8(bs);
        const float inv = rsqrtf(ss + 1e-6f);
        if ((tid & 7) == 0) gBS[t] = bs;
        float oKap[8], oBet[8], oKti[8], oRho[8], oBd[8], oKd[8];
#pragma unroll
        for (int e = 0; e < 8; ++e) { kn[e] *= inv; bb[e] *= kn[e];
            const float g = Af[t * 64 + c8 + e], gp = t > 0 ? Af[(t - 1) * 64 + c8 + e] : 0.f, gl = Af[63 * 64 + c8 + e];
            const float eg = __expf(g), ing = __expf(-g), egl = __expf(gl - g);
            oKap[e] = kn[e] * __expf(gp); oBet[e] = bb[e] * ing; oKti[e] = km[e] * ing; oRho[e] = r[e] * eg; oBd[e] = bb[e] * egl; oKd[e] = km[e] * egl; }
        const int lo = (t * 72 + c8) * 2;
#define ST8(dstp, a) do { u32x4 _w; _w.x = cvt_pk_bf16((a)[0], (a)[1]); _w.y = cvt_pk_bf16((a)[2], (a)[3]); _w.z = cvt_pk_bf16((a)[4], (a)[5]); _w.w = cvt_pk_bf16((a)[6], (a)[7]); *(u32x4*)(dstp) = _w; } while (0)
        ST8(sKap + lo, oKap); ST8(sBet + lo, oBet); ST8(sKti + lo, oKti); ST8(sRho + lo, oRho);
#define STT(base, a) do { _Pragma("unroll") for (int e_ = 0; e_ < 8; e_ += 2) { const unsigned w_ = cvt_pk_bf16((a)[e_], (a)[e_ + 1]); \
            *(bf16_t*)((base) + ((c8 + e_) * 72 + t) * 2) = (bf16_t)(w_ & 0xffffu); *(bf16_t*)((base) + ((c8 + e_ + 1) * 72 + t) * 2) = (bf16_t)(w_ >> 16); } } while (0)
        STT(X1, oKap); STT(sBd, oBd); STT(sKd, oKd); STT(sV, v);
#undef STT
#undef ST8
    }
    if (next_job >= 0) rw_load(p, next_job, in, tid);
    __syncthreads();
    {
        const int pidx = wave >> 1, tt0 = (wave & 1) * 2;
        const unsigned char* Xop = (pidx < 2) ? sKap : sRho; const unsigned char* Yop = (pidx & 1) ? sKti : sBet;
        unsigned char* dstb = pidx == 1 ? sBm : (pidx == 2 ? sAb : sAk);
#pragma unroll
        for (int q = 0; q < 2; ++q) { const int tt = tt0 + q, t = tt * 16 + l15;
            const bf16x8 x0 = ldfrag(Xop, 72, tt * 16, 0, lane), x1 = ldfrag(Xop, 72, tt * 16, 32, lane);
            bf16x8 yf[4][2]; f32x4 accs[4];
#pragma unroll
            for (int it = 0; it < 4; ++it) { yf[it][0] = ldfrag(Yop, 72, it * 16, 0, lane); yf[it][1] = ldfrag(Yop, 72, it * 16, 32, lane); }
#pragma unroll
            for (int it = 0; it < 4; ++it) accs[it] = MFMA16(yf[it][0], x0, ((f32x4){0.f, 0.f, 0.f, 0.f}));
#pragma unroll
            for (int it = 0; it < 4; ++it) accs[it] = MFMA16(yf[it][1], x1, accs[it]);
#pragma unroll
            for (int it = 0; it < 4; ++it) { f32x4 acc = accs[it];
                const int i0 = it * 16 + quad * 4;
#pragma unroll
                for (int j = 0; j < 4; ++j) { const bool keep = (pidx < 2) ? (i0 + j < t) : (i0 + j <= t); acc[j] = keep ? acc[j] : 0.f; }
                if (pidx == 0) *(f32x4*)(Af + t * 64 + i0) = acc; else *(u32x2*)(dstb + (t * 72 + i0) * 2) = PACK4(acc);
            } }
    }
    __syncthreads();
    inverse64(Af, Zf, sT, tid);
    {
        const int prod = wave >> 2, ct = wave & 3;
        const unsigned char* Asrc = prod ? sBm : sT; const unsigned char* Bsrc = prod ? sV : X1; unsigned char* dst = prod ? sX : sP1;
        const bf16x8 b0 = ldfrag(Bsrc, 72, ct * 16, 0, lane), b1 = ldfrag(Bsrc, 72, ct * 16, 32, lane);
        bf16x8 af[4][2]; f32x4 accs[4];
#pragma unroll
        for (int tt = 0; tt < 4; ++tt) { af[tt][0] = ldfrag(Asrc, 72, tt * 16, 0, lane); af[tt][1] = ldfrag(Asrc, 72, tt * 16, 32, lane); }
#pragma unroll
        for (int tt = 0; tt < 4; ++tt) accs[tt] = MFMA16(af[tt][0], b0, ((f32x4){0.f, 0.f, 0.f, 0.f}));
#pragma unroll
        for (int tt = 0; tt < 4; ++tt) accs[tt] = MFMA16(af[tt][1], b1, accs[tt]);
#pragma unroll
        for (int tt = 0; tt < 4; ++tt) *(u32x2*)(dst + ((ct * 16 + l15) * 72 + tt * 16 + quad * 4) * 2) = PACK4(accs[tt]);
    }
    __syncthreads();
    {
        const int vt = wave & 3, tt0 = (wave >> 2) * 2;
        const bf16x8 b0 = ldfrag(sX, 72, vt * 16, 0, lane), b1 = ldfrag(sX, 72, vt * 16, 32, lane);
        f32x4 acc[2]; bf16x8 tf[2][2];
#pragma unroll
        for (int q = 0; q < 2; ++q) { tf[q][0] = ldfrag(sT, 72, (tt0 + q) * 16, 0, lane); tf[q][1] = ldfrag(sT, 72, (tt0 + q) * 16, 32, lane); }
#pragma unroll
        for (int q = 0; q < 2; ++q) acc[q] = MFMA16(tf[q][0], b0, ((f32x4){0.f, 0.f, 0.f, 0.f}));
#pragma unroll
        for (int q = 0; q < 2; ++q) acc[q] = MFMA16(tf[q][1], b1, acc[q]);
#pragma unroll
        for (int q = 0; q < 2; ++q) *(u32x2*)(sP2 + ((vt * 16 + l15) * 72 + (tt0 + q) * 16 + quad * 4) * 2) = PACK4(acc[q]);
    }
    __syncthreads();
    {
        const int c = wave & 3, half = wave >> 2;
        const bf16x8 gp1a = ldfrag(sP1, 72, c * 16, 0, lane), gp1b = ldfrag(sP1, 72, c * 16, 32, lane);
        const bf16x8 gva = ldfrag(sV, 72, c * 16, 0, lane), gvb = ldfrag(sV, 72, c * 16, 32, lane);
        const bf16x8 gp2a = ldfrag(sP2, 72, c * 16, 0, lane), gp2b = ldfrag(sP2, 72, c * 16, 32, lane);
        bf16x8 gbd[2][2], gkd[2][2];
#pragma unroll
        for (int q = 0; q < 2; ++q) { const int kt = half * 2 + q;
            gbd[q][0] = ldfrag(sBd, 72, kt * 16, 0, lane); gbd[q][1] = ldfrag(sBd, 72, kt * 16, 32, lane);
            gkd[q][0] = ldfrag(sKd, 72, kt * 16, 0, lane); gkd[q][1] = ldfrag(sKd, 72, kt * 16, 32, lane); }
        const f32x4 zero4 = {0.f, 0.f, 0.f, 0.f};
#pragma unroll
        for (int q = 0; q < 2; ++q) { const int tt = half * 2 + q;
            const bf16x8 ab0 = ldfrag(sAb, 72, tt * 16, 0, lane), ab1 = ldfrag(sAb, 72, tt * 16, 32, lane), ak0 = ldfrag(sAk, 72, tt * 16, 0, lane), ak1 = ldfrag(sAk, 72, tt * 16, 32, lane);
            f32x4 aq = MFMA16(gp1a, ab0, zero4), a1 = MFMA16(ak0, gva, zero4), a2 = MFMA16(ab0, gp2a, zero4);
            aq = MFMA16(gp1b, ab1, aq); a1 = MFMA16(ak1, gvb, a1); a2 = MFMA16(ab1, gp2b, a2);
            const int t = tt * 16 + l15, k0 = c * 16 + quad * 4;
            const u32x2 rw = *(const u32x2*)(sRho + (t * 72 + k0) * 2);
            f32x4 ovq = {bf_lo(rw.x) - aq[0], bf_hi(rw.x) - aq[1], bf_lo(rw.y) - aq[2], bf_hi(rw.y) - aq[3]};
            *(u32x2*)(gQ + t * 64 + k0) = PACK4(ovq);
            f32x4 ovy = a1 - a2;
            *(u32x2*)(gY0 + ((tt * 4 + c) * 64 + lane) * 4) = PACK4(ovy); }
#pragma unroll
        for (int q = 0; q < 2; ++q) { const int kt = half * 2 + q;
            f32x4 af = MFMA16(gp1a, gbd[q][0], zero4), a1 = MFMA16(gkd[q][0], gva, zero4), a2 = MFMA16(gbd[q][0], gp2a, zero4);
            af = MFMA16(gp1b, gbd[q][1], af); a1 = MFMA16(gkd[q][1], gvb, a1); a2 = MFMA16(gbd[q][1], gp2b, a2);
            f32x4 ovf = {-af[0], -af[1], -af[2], -af[3]};
            *(u32x2*)(gF + (kt * 16 + l15) * 64 + c * 16 + quad * 4) = PACK4(ovf);
            f32x4 ovs = a1 - a2;
            *(u32x2*)(gS0 + ((kt * 4 + c) * 64 + lane) * 4) = PACK4(ovs); }
    }
    __syncthreads();
}

struct RwSet { u32x4 pq, pf; u32x2 py[4], ps[4]; float wc1; u32x4 cv, qv, gt; float bsc; };
__device__ __forceinline__ void rw_fetch(const Params& p, RwSet& s, int bh, int n, int b, int chn, int tid, int wave, int lane, int quad) {
    const bf16_t* P = (const bf16_t*)(p.ws + WS_P);
    const unsigned char* blk = rwp_ptr(p, bh * NCH + n);
    const int w4 = wave & 3;
    s.pq = *(const u32x4*)(blk + tid * 16); s.pf = *(const u32x4*)(blk + 8192 + tid * 16);
#pragma unroll
    for (int i = 0; i < 4; ++i) { s.py[i] = *(const u32x2*)(blk + 16384 + (((i * 4 + w4) * 64 + lane) * 8)); s.ps[i] = *(const u32x2*)(blk + 24576 + (((i * 4 + w4) * 64 + lane) * 8)); }
    s.wc1 = ((const float*)(blk + 32768))[tid & 63];
    const int tp = n * 64 + (tid >> 3) - 48, tpc = tp < 0 ? 0 : tp, tpp = tp < 1 ? 0 : tp - 1;
    const bf16_t* rowp = P + (size_t)rowof(b, tpc) * NP + chn;
    s.cv = *(const u32x4*)(rowp + C_V); s.gt = *(const u32x4*)(rowp + C_G); s.bsc = ((const float*)(blk + 33024))[tid >> 3];
    s.qv = *(const u32x4*)(P + (size_t)rowof(b, tpp) * NP + chn + C_V);
    if (tp < 1) s.qv = (u32x4){0u, 0u, 0u, 0u};
}
__device__ __forceinline__ void rw_chunk(const Params& p, RwSet& s, f32x4 (&S)[4], int bh, int n, int b, int chn, int tid, int wave, int lane, int l15, int quad,
                                         unsigned char* Ql, unsigned char* Fl, unsigned char* St, float* Yl, const float* Cst) {
    bf16_t* P = (bf16_t*)(p.ws + WS_P);
    const int pt = tid >> 3, pc8 = (tid & 7) * 8;
    __syncthreads();
    *(u32x4*)(Ql + ((tid >> 3) * 72 + (tid & 7) * 8) * 2) = s.pq; *(u32x4*)(Fl + ((tid >> 3) * 72 + (tid & 7) * 8) * 2) = s.pf;
    f32x4 y[4], sadd[4];
#pragma unroll
    for (int i = 0; i < 4; ++i) { y[i] = (f32x4){bf_lo(s.py[i].x), bf_hi(s.py[i].x), bf_lo(s.py[i].y), bf_hi(s.py[i].y)};
        sadd[i] = (f32x4){bf_lo(s.ps[i].x), bf_hi(s.ps[i].x), bf_lo(s.ps[i].y), bf_hi(s.ps[i].y)}; }
    float* WCl = Yl + 64 * 68 + 192;
    if (tid < 64) WCl[tid] = s.wc1;
    const u32x4 cv = s.cv, qv = s.qv, gt = s.gt; const float bsc = s.bsc;
    const int tp = n * 64 + pt - 48; const bool valid = tp >= 0;
    __syncthreads();
    if (n + 2 < NCH) rw_fetch(p, s, bh, n + 2, b, chn, tid, wave, lane, quad);
    if (wave < 4) {
#pragma unroll
        for (int kt = 0; kt < 4; ++kt) *(u32x2*)(St + (l15 * 72 + kt * 16 + quad * 4) * 2) = PACK4(S[kt]);
        asm volatile("s_waitcnt lgkmcnt(0)" ::: "memory");
        const bf16x8 sf0 = ldfrag(St, 72, 0, 0, lane), sf1 = ldfrag(St, 72, 0, 32, lane);
        bf16x8 fq[4][2], ff[4][2];
#pragma unroll
        for (int i = 0; i < 4; ++i) { ff[i][0] = ldfrag(Fl, 72, i * 16, 0, lane); ff[i][1] = ldfrag(Fl, 72, i * 16, 32, lane); }
#pragma unroll
        for (int i = 0; i < 4; ++i) { fq[i][0] = ldfrag(Ql, 72, i * 16, 0, lane); fq[i][1] = ldfrag(Ql, 72, i * 16, 32, lane); }
        f32x4 sn[4];
#pragma unroll
        for (int kt = 0; kt < 4; ++kt) sn[kt] = S[kt] * *(const f32x4*)(WCl + kt * 16 + quad * 4) + sadd[kt];
#pragma unroll
        for (int kt = 0; kt < 4; ++kt) sn[kt] = MFMA16(ff[kt][0], sf0, sn[kt]);
#pragma unroll
        for (int kt = 0; kt < 4; ++kt) S[kt] = MFMA16(ff[kt][1], sf1, sn[kt]);
#pragma unroll
        for (int ct = 0; ct < 4; ++ct) y[ct] = MFMA16(fq[ct][0], sf0, y[ct]);
#pragma unroll
        for (int ct = 0; ct < 4; ++ct) y[ct] = MFMA16(fq[ct][1], sf1, y[ct]);
#pragma unroll
        for (int ct = 0; ct < 4; ++ct)
#pragma unroll
            for (int j = 0; j < 4; ++j) Yl[(ct * 16 + quad * 4 + j) * 68 + wave * 16 + l15] = y[ct][j];
    }
    __syncthreads();
    {
        const f32x4 y0 = *(const f32x4*)(Yl + pt * 68 + pc8), y1 = *(const f32x4*)(Yl + pt * 68 + pc8 + 4);
        float yv[8] = {y0[0], y0[1], y0[2], y0[3], y1[0], y1[1], y1[2], y1[3]};
        float sm = 0.f;
#pragma unroll
        for (int e = 0; e < 8; ++e) sm += yv[e];
        sm = sum8(sm); const float mean = sm * (1.f / 64.f);
        float sq = 0.f;
#pragma unroll
        for (int e = 0; e < 8; ++e) { yv[e] -= mean; sq += yv[e] * yv[e]; }
        sq = sum8(sq); const float rstd = rsqrtf(sq * (1.f / 64.f) + 64e-5f);
        float ov[8], muv[8], gw[8], gb[8];
#pragma unroll
        for (int e = 0; e < 8; ++e) { muv[e] = Cst[pc8 + e]; gw[e] = Cst[64 + pc8 + e]; gb[e] = Cst[128 + pc8 + e]; }
#pragma unroll
        for (int e = 0; e < 4; ++e) {
            const float c0 = bf_lo(cv[e]), c1 = bf_hi(cv[e]);
            const float v0 = c0 + (bf_lo(qv[e]) - c0) * muv[2 * e], v1 = c1 + (bf_hi(qv[e]) - c1) * muv[2 * e + 1];
            ov[2 * e] = (yv[2 * e] * rstd * gw[2 * e] + gb[2 * e] + bsc * v0) * siluf_(bf_lo(gt[e]));
            ov[2 * e + 1] = (yv[2 * e + 1] * rstd * gw[2 * e + 1] + gb[2 * e + 1] + bsc * v1) * siluf_(bf_hi(gt[e])); }
        if (valid) { u32x4 w; w.x = cvt_pk_bf16(ov[0], ov[1]); w.y = cvt_pk_bf16(ov[2], ov[3]); w.z = cvt_pk_bf16(ov[4], ov[5]); w.w = cvt_pk_bf16(ov[6], ov[7]);
            *(u32x4*)(P + (size_t)rowof(b, tp) * NP + chn + C_G) = w; }
    }
}
__device__ __forceinline__ void rw_scan(const Params& p, int bh, unsigned char* lds) {
    const int b = bh >> 4, h = bh & 15, tid = opaque_tid(), lane = tid & 63, wave = tid >> 6, l15 = lane & 15, quad = lane >> 4;
    unsigned char* Ql = lds; unsigned char* Fl = lds + 9216;
    unsigned char* St = lds + 18432 + (wave & 3) * 2304;
    float* Yl = (float*)(lds + 27648);
    f32x4 S[4];
#pragma unroll
    for (int i = 0; i < 4; ++i) S[i] = (f32x4){0.f, 0.f, 0.f, 0.f};
    const int chn = h * 64 + (tid & 7) * 8;
    float* Cst = (float*)(lds + 45056);
    if (tid < 64) { Cst[tid] = p.mu[C_V + h * 64 + tid]; Cst[64 + tid] = p.gn_w[h * 64 + tid]; Cst[128 + tid] = p.gn_b[h * 64 + tid]; }
    RwSet s0, s1;
#pragma unroll
    for (int i = 0; i < 4; ++i) { s0.py[i] = (u32x2){0u, 0u}; s0.ps[i] = (u32x2){0u, 0u}; s1.py[i] = s0.py[i]; s1.ps[i] = s0.ps[i]; }
    rw_fetch(p, s0, bh, 0, b, chn, tid, wave, lane, quad);
    rw_fetch(p, s1, bh, 1, b, chn, tid, wave, lane, quad);
#pragma unroll 1
    for (int n = 0; n + 3 < NCH; n += 4) {
        rw_chunk(p, s0, S, bh, n, b, chn, tid, wave, lane, l15, quad, Ql, Fl, St, Yl, Cst);
        rw_chunk(p, s1, S, bh, n + 1, b, chn, tid, wave, lane, l15, quad, Ql, Fl, St, Yl, Cst);
        rw_chunk(p, s0, S, bh, n + 2, b, chn, tid, wave, lane, l15, quad, Ql, Fl, St, Yl, Cst);
        rw_chunk(p, s1, S, bh, n + 3, b, chn, tid, wave, lane, l15, quad, Ql, Fl, St, Yl, Cst);
    }
    static_assert(NCH % 4 == 1, "tail below handles exactly one chunk");
    rw_chunk(p, s0, S, bh, NCH - 1, b, chn, tid, wave, lane, l15, quad, Ql, Fl, St, Yl, Cst);
}
__global__ void __launch_bounds__(512, 2) hymba_fwd(Params p) {
    extern __shared__ __attribute__((aligned(16))) unsigned char lds[];
    cg::grid_group grid = cg::this_grid();
#define GSYNC() do { asm volatile("s_waitcnt vmcnt(0)" ::: "memory"); grid.sync(); \
        if (threadIdx.x < 64) { __builtin_amdgcn_fence(__ATOMIC_ACQUIRE, "agent"); asm volatile("s_waitcnt vmcnt(0)" ::: "memory"); } __syncthreads(); } while (0)
    const int G = gridDim.x, bid = blockIdx.x;
    volatile LAS unsigned* xbst = (volatile LAS unsigned*)((LAS unsigned char*)lds + (LDS_BYTES - 16));
    if (threadIdx.x == 0) { xbst[0] = 0u; xbst[1] = 0u; }
    __syncthreads();
    const XcdBarrier xbar = xcd_barrier_post((unsigned*)(p.ws + WS_BAR), xbst);
    bf16_t* P = (bf16_t*)(p.ws + WS_P);
    GSYNC();
    phase0(p, lds);
    xcd_barrier(xbar);
    {
        pg8::Gemm g{(const bf16_t*)(p.ws + WS_U), (const bf16_t*)(p.ws + WS_WINT), MP, NP, DM, DM};
        pg8::EpiBf16 E{P, NP};
        if (G == 256) { pg8::MainOrder2048 S; S.G = G; S.c = bid; pg8::gemm_phase<pg8::EpiBf16, pg8::MainOrder2048, true, true>((PG8_LAS unsigned char*)lds, g, S, E); }
        else { pg8::StaticOrder S; S.init(MP, NP, G, bid); pg8::gemm_phase<pg8::EpiBf16, pg8::StaticOrder, true, true>((PG8_LAS unsigned char*)lds, g, S, E); }
    }
    xcd_barrier(xbar);
    if (G == 256 && bid < 97) {
        pg8::Gemm g{(const bf16_t*)(p.ws + WS_U), (const bf16_t*)(p.ws + WS_WINT), MP, NP, DM, DM};
        pg8::EpiBf16 E{P, NP};
        pg8::LeftOrder97 S; S.c = bid;
        pg8::gemm_phase<pg8::EpiBf16, pg8::LeftOrder97, true, true>((PG8_LAS unsigned char*)lds, g, S, E);
    }
    {
        RwIn rin; int job = bid, stride = G, end = 64 * NCH;
        if (G == 256) { constexpr int NA = 97, JA = 14;
            if (bid < NA) { job = bid; stride = NA; end = NA * JA; } else { job = NA * JA + (bid - NA); stride = G - NA; } }
#pragma unroll
        for (int i = 0; i < 4; ++i) rin.mul[i] = *(const f32x4*)(p.mu + 3072 + (threadIdx.x & 7) * 16 + 4 * i);
        if (job < end) rw_load(p, job, rin, threadIdx.x);
        for (; job < end; job += stride) rw_prep(p, job, lds, rin, job + stride < end ? job + stride : -1);
    }
    {
        DnIn din; int job = (bid + 192) % G;
        if (job < 32 * NCH) dn_load(p, job, din, threadIdx.x);
        for (; job < 32 * NCH; job += G) dn_prep(p, job, lds, din, job + G < 32 * NCH ? job + G : -1);
    }
    xcd_barrier(xbar);
    for (int job = bid; job < 64 + 32 * DN_PARTS; job += G) {
        if (job < 64) rw_scan(p, job, lds);
        else { const int q = job - 64, grp = q / (8 * DN_PARTS), r = q % (8 * DN_PARTS);
               dn_scan(p, grp * 8 + (r & 7), r >> 3, lds); }
        __syncthreads();
    }
    xcd_barrier(xbar);
    {
        const int tidp = opaque_tid(); DnPostIn pin, cur; int job = bid;
        if (job < 32 * NCH) dn_post_load(p, job, pin, tidp);
        for (; job < 32 * NCH; job += G) { cur = pin; if (job + G < 32 * NCH) dn_post_load(p, job + G, pin, tidp); dn_post(p, job, cur, tidp); }
    }
    xcd_barrier(xbar);
    if (G == 256) {
        pg8::Gemm g{P + C_G, (const bf16_t*)(p.ws + WS_WOUTT), NREAL, DM, DM, NP};
        pg8::PanelOrder S; S.c = bid;
        pg8::EpiResidNorm E{p.x, p.out, DM, (float*)(p.ws + WS_ROWSS), (unsigned*)(p.ws + WS_CNT), p.fnorm_w};
        pg8::gemm_phase<pg8::EpiResidNorm, pg8::PanelOrder, false, true>((PG8_LAS unsigned char*)lds, g, S, E);
    } else {
        {
            pg8::Gemm g{P + C_G, (const bf16_t*)(p.ws + WS_WOUTT), NREAL, DM, DM, NP};
            pg8::StaticOrder S; S.init(NREAL, DM, G, bid);
            pg8::EpiResid E{p.x, p.out, DM, (float*)(p.ws + WS_ROWSS)};
            pg8::gemm_phase<pg8::EpiResid, pg8::StaticOrder>((PG8_LAS unsigned char*)lds, g, S, E);
        }
        xcd_barrier(xbar);
        phase_final(p);
    }
}

extern "C" void kernel_launch(void* const* d_in, const int* in_sizes, int n_in, void* d_out, int out_size, void* d_ws, size_t ws_size, hipStream_t stream) {
    static int grid_blocks = 0;
    if (grid_blocks == 0) {
        if (n_in != 20 || ws_size < WS_END) { fprintf(stderr, "kernel_launch: unexpected n_in %d / ws_size %zu (need %zu)\n", n_in, ws_size, (size_t)WS_END); grid_blocks = -1; return; }
        int dev = 0, cus = 0, per_cu = 0;
        (void)hipGetDevice(&dev);
        (void)hipDeviceGetAttribute(&cus, hipDeviceAttributeMultiprocessorCount, dev);
        if (hipFuncSetAttribute((const void*)hymba_fwd, hipFuncAttributeMaxDynamicSharedMemorySize, LDS_BYTES) != hipSuccess) { fprintf(stderr, "kernel_launch: hipFuncSetAttribute failed\n"); grid_blocks = -1; return; }
        (void)hipOccupancyMaxActiveBlocksPerMultiprocessor(&per_cu, (const void*)hymba_fwd, 512, LDS_BYTES);
        (void)hipGetLastError();
        if (per_cu < 1) per_cu = 1;
        grid_blocks = cus * per_cu;
        if (grid_blocks > 256) grid_blocks = 256;
    }
    if (grid_blocks < 0) return;
    Params p{};
    p.x = (const float*)d_in[0]; p.meta = (const float*)d_in[1]; p.norm_w = (const float*)d_in[2]; p.w_in = (const float*)d_in[3]; p.mu = (const float*)d_in[4];
    p.w0 = (const float*)d_in[5]; p.w2 = (const float*)d_in[6]; p.a0 = (const float*)d_in[7]; p.a2 = (const float*)d_in[8]; p.k_k = (const float*)d_in[9];
    p.k_a = (const float*)d_in[10]; p.r_k = (const float*)d_in[11]; p.gn_w = (const float*)d_in[12]; p.gn_b = (const float*)d_in[13]; p.conv_w = (const float*)d_in[14];
    p.A_log = (const float*)d_in[15]; p.dt_bias = (const float*)d_in[16]; p.dn_norm_w = (const float*)d_in[17]; p.w_out = (const float*)d_in[18]; p.fnorm_w = (const float*)d_in[19];
    p.out = (float*)d_out; p.ws = (unsigned char*)d_ws;
    (void)hipMemsetAsync((unsigned char*)d_ws + WS_BAR, 0, 16384 + 128 * 256, stream);
    void* args[] = {&p};
    hipError_t e = hipLaunchCooperativeKernel((const void*)hymba_fwd, dim3(grid_blocks), dim3(512), args, LDS_BYTES, stream);
    if (e != hipSuccess) fprintf(stderr, "cooperative launch failed: %s (grid %d)\n", hipGetErrorString(e), grid_blocks);
}
```
